# Optimizing an MI355X kernel written in HIP

```python
import math
import jax
import jax.numpy as jnp
from jax import lax
import numpy as np

D_MODEL = 2048
BATCH = 1
SEQ = 8192
DEPTH = 4

N_A_LAYERS = DEPTH // 2
N_B_LAYERS = DEPTH - N_A_LAYERS
RW_HEAD = 64
RW_HEADS = D_MODEL // RW_HEAD
LORA_DECAY = 96
LORA_A = 128
LORA_V = 64
LORA_G = 256
N_SHIFT_MIX = 6
GN_EPS = 64e-5
NSA_HEADS = 16
NSA_GROUPS = 4
NSA_REP = NSA_HEADS // NSA_GROUPS
NSA_HD = D_MODEL // NSA_HEADS
N_KV_PARTS = 6
CMP_STRIDE = 16
CMP_LEN = 2 * CMP_STRIDE
SEL_BLOCK = 64
SEL_TOP = 16
WINDOW = 512
QBLK = 128
N_BRANCH = 3
SEL_FORCE = 1e4
NEG_INF = -1e30
REL_BUCKETS = 32
REL_MAX_DIST = 128
D_FF = 4 * D_MODEL
NORM_EPS = 1e-6

kernel_name = 'rwkv7_nsa_yoco_hybrid'


def rmsnorm(x, g):
    xf = x.astype(jnp.float32)
    y = xf * lax.rsqrt(jnp.mean(xf * xf, axis=-1, keepdims=True) + NORM_EPS)
    return (y * g.astype(jnp.float32)).astype(x.dtype)


def t5_bucket(dist):
    n = jnp.maximum(dist, 0)
    max_exact = REL_BUCKETS // 2
    nf = jnp.maximum(n, 1).astype(jnp.float32)
    large = max_exact + (jnp.log(nf / max_exact) / math.log(REL_MAX_DIST / max_exact)
                         * (REL_BUCKETS - max_exact)).astype(jnp.int32)
    large = jnp.minimum(large, REL_BUCKETS - 1)
    return jnp.where(n < max_exact, n, large)


def sqrelu_mlp(xn, w_up, w_down):
    return jnp.square(jax.nn.relu(xn @ w_up)) @ w_down


def _rwkv7_step(S, inp):
    r, w, k, v, a, b = inp
    sa = jnp.einsum('bhij,bhj->bhi', S, a)
    S = S * w[:, :, None, :] + sa[..., None] * b[:, :, None, :] + v[..., None] * k[:, :, None, :]
    return S, jnp.einsum('bhij,bhj->bhi', S, r)


def rwkv7_time_mix(xn, mu, wr, wk, wv, wo, w0, w1, w2, a0, a1, a2, g1, g2,
                   k_k, k_a, r_k, lnx_w, lnx_b, v_first, v0, v1, v2):
    B, T, C = xn.shape
    H, N = RW_HEADS, RW_HEAD
    f32 = jnp.float32
    xx = jnp.pad(xn[:, :-1], ((0, 0), (1, 0), (0, 0))) - xn
    xr, xw, xk, xv, xa, xg = [xn + xx * mu[i] for i in range(N_SHIFT_MIX)]
    r = xr @ wr
    w = -jax.nn.softplus(-(w0 + jnp.tanh(xw @ w1) @ w2)) - 0.5
    k = xk @ wk
    v = xv @ wv
    if v_first is None:
        v_first = v
    else:
        v = v + (v_first - v) * jax.nn.sigmoid(v0 + (xv @ v1) @ v2)
    a = jax.nn.sigmoid(a0 + (xa @ a1) @ a2)
    g = jax.nn.sigmoid(xg @ g1) @ g2
    kk = (k * k_k).astype(f32).reshape(B, T, H, N)
    kk = kk * lax.rsqrt(jnp.maximum(jnp.sum(kk * kk, -1, keepdims=True), 1e-24))
    k = k * (1.0 + (a - 1.0) * k_a)

    def heads(u):
        return u.astype(f32).reshape(B, T, H, N)

    rf, kf, vf, af = heads(r), heads(k), heads(v), heads(a)
    decay = jnp.exp(-jnp.exp(heads(w)))
    xs = tuple(jnp.moveaxis(u, 1, 0) for u in (rf, decay, kf, vf, -kk, kk * af))
    S0 = jnp.zeros((B, H, N, N), f32)
    _, y = lax.scan(_rwkv7_step, S0, xs)
    y = jnp.moveaxis(y, 0, 1)
    mean = jnp.mean(y, -1, keepdims=True)
    var = jnp.mean(jnp.square(y - mean), -1, keepdims=True)
    y = ((y - mean) * lax.rsqrt(var + GN_EPS)).reshape(B, T, C) * lnx_w + lnx_b
    bonus = (jnp.sum(rf * kf * r_k, -1, keepdims=True) * vf).reshape(B, T, C)
    out = ((y + bonus) * g).astype(xn.dtype) @ wo
    return out, v_first


def compress_blocks(u, pe, w1, b1, w2):
    B, T, G, D = u.shape
    u16 = u.reshape(B, T // CMP_STRIDE, CMP_STRIDE, G, D)
    blocks = jnp.concatenate([u16[:, :-1], u16[:, 1:]], axis=2) + pe[None, None, :, None, :]
    flat = blocks.transpose(0, 1, 3, 2, 4).reshape(B, T // CMP_STRIDE - 1, G, CMP_LEN * D)
    return jax.nn.gelu(flat @ w1 + b1) @ w2


def nsa_shared_kv(h, kv_norm_g, w_kv, cmp_pe, cmp_w1, cmp_b1, cmp_w2):
    B, T, _ = h.shape
    G, D = NSA_GROUPS, NSA_HD
    kv = (rmsnorm(h, kv_norm_g) @ w_kv).reshape(B, T, N_KV_PARTS, G, D)
    kc = compress_blocks(kv[:, :, 0], cmp_pe[0], cmp_w1[0], cmp_b1[0], cmp_w2[0])
    vc = compress_blocks(kv[:, :, 1], cmp_pe[1], cmp_w1[1], cmp_b1[1], cmp_w2[1])
    n_s = T // SEL_BLOCK
    ks = kv[:, :, 2].reshape(B, n_s, SEL_BLOCK, G, D).transpose(0, 3, 1, 2, 4)
    vs = kv[:, :, 3].reshape(B, n_s, SEL_BLOCK, G, D).transpose(0, 3, 1, 2, 4)
    pad = ((0, 0), (WINDOW, 0), (0, 0), (0, 0))
    kw = jnp.pad(kv[:, :, 4], pad)
    vw = jnp.pad(kv[:, :, 5], pad)
    return kc, vc, ks, vs, kw, vw


def nsa_attention(hn, wq, wo, rel_bias, kc, vc, ks, vs, kw, vw):
    B, T, _ = hn.shape
    G, R, D = NSA_GROUPS, NSA_REP, NSA_HD
    f32 = jnp.float32
    n_c = kc.shape[1]
    n_s = ks.shape[2]
    top = min(SEL_TOP, n_s)
    n_qb = T // QBLK
    proj = hn @ wq
    q = (proj[..., :NSA_HEADS * D] * (D ** -0.5)).reshape(B, n_qb, QBLK, G, R, D).transpose(1, 0, 2, 3, 4, 5)
    gates = jax.nn.sigmoid(proj[..., NSA_HEADS * D:].astype(f32)).reshape(
        B, n_qb, QBLK, G, R, N_BRANCH).transpose(1, 0, 2, 3, 4, 5)
    table = rel_bias.astype(f32)
    table_g = table.reshape(REL_BUCKETS, G, R).transpose(1, 0, 2)
    cmp_end = jnp.arange(n_c) * CMP_STRIDE + (CMP_LEN - 1)
    blk_start = jnp.arange(n_s) * SEL_BLOCK
    overlap = (((cmp_end[:, None] - (CMP_LEN - 1)) <= (blk_start[None, :] + SEL_BLOCK - 1))
               & (cmp_end[:, None] >= blk_start[None, :])).astype(f32)
    b_idx = jnp.arange(B)[:, None, None, None]
    g_idx = jnp.arange(G)[None, :, None, None]
    sel_off = jnp.arange(SEL_BLOCK)

    def head_bias(dist):
        bias = table[t5_bucket(dist)]
        return bias.reshape(dist.shape + (G, R)).transpose(2, 3, 0, 1)

    def block(args):
        qb, gb, qi = args
        t = qi * QBLK + jnp.arange(QBLK)
        m_c = cmp_end[None, :] <= t[:, None]
        s_c = jnp.einsum('bqgrd,bcgd->bgrqc', qb, kc).astype(f32) + head_bias(t[:, None] - cmp_end[None, :])
        p_c = jnp.where(m_c, jax.nn.softmax(jnp.where(m_c, s_c, NEG_INF), axis=-1), 0.0)
        o_c = jnp.einsum('bgrqc,bcgd->bqgrd', p_c, vc)
        imp = jnp.einsum('bgrqc,cs->bgqs', p_c, overlap)
        blk_ok = blk_start[None, :] <= t[:, None]
        forced = (blk_start[None, :] == (t[:, None] // SEL_BLOCK) * SEL_BLOCK) | (blk_start[None, :] == 0)
        score = jnp.where(forced, SEL_FORCE, jnp.where(blk_ok, imp, -SEL_FORCE))
        _, idx = lax.top_k(score, top)
        k_sel = ks[b_idx, g_idx, idx]
        v_sel = vs[b_idx, g_idx, idx]
        dist_s = t[None, None, :, None, None] - (idx[..., None] * SEL_BLOCK + sel_off)
        m_s = dist_s >= 0
        bias_s = jnp.moveaxis(table_g[g_idx[..., None], t5_bucket(dist_s)], -1, 2)
        s_s = jnp.einsum('bqgrd,bgqkld->bgrqkl', qb, k_sel).astype(f32) + bias_s
        s_s = jnp.where(m_s[:, :, None], s_s, NEG_INF).reshape(B, G, R, QBLK, top * SEL_BLOCK)
        p_s = jax.nn.softmax(s_s, axis=-1).reshape(B, G, R, QBLK, top, SEL_BLOCK)
        o_s = jnp.einsum('bgrqkl,bgqkld->bqgrd', p_s, v_sel)
        kwb = lax.dynamic_slice_in_dim(kw, qi * QBLK, WINDOW + QBLK, axis=1)
        vwb = lax.dynamic_slice_in_dim(vw, qi * QBLK, WINDOW + QBLK, axis=1)
        kpos = qi * QBLK - WINDOW + jnp.arange(WINDOW + QBLK)
        dist_w = t[:, None] - kpos[None, :]
        m_w = (dist_w >= 0) & (dist_w < WINDOW) & (kpos[None, :] >= 0)
        s_w = jnp.einsum('bqgrd,bkgd->bgrqk', qb, kwb).astype(f32) + head_bias(dist_w)
        p_w = jax.nn.softmax(jnp.where(m_w, s_w, NEG_INF), axis=-1)
        o_w = jnp.einsum('bgrqk,bkgd->bqgrd', p_w, vwb)
        o = gb[..., 0:1] * o_c + gb[..., 1:2] * o_s + gb[..., 2:3] * o_w
        return o.astype(hn.dtype)

    out = lax.map(block, (q, gates, jnp.arange(n_qb)))
    out = out.transpose(1, 0, 2, 3, 4, 5).reshape(B, T, NSA_HEADS * D)
    return out @ wo


def setup_inputs(seed: int = 0) -> dict:
    key = jax.random.key(seed)
    keys = iter(jax.random.split(key, 48))
    f32 = jnp.float32

    def nrm(shape, scale):
        return jax.random.normal(next(keys), shape, f32) * scale

    def gain(shape):
        return 1.0 + 0.02 * jax.random.normal(next(keys), shape, f32)

    def unif(shape, lo, hi):
        return jax.random.uniform(next(keys), shape, f32, lo, hi)

    nA, nB, D = N_A_LAYERS, N_B_LAYERS, D_MODEL
    H, N = RW_HEADS, RW_HEAD
    HB, G, HD = NSA_HEADS, NSA_GROUPS, NSA_HD
    sD = D ** -0.5
    return {
        'x': nrm((BATCH, SEQ, D), 1.0),
        'a_norm_g': gain((nA, D)),
        'rw_mu': unif((nA, N_SHIFT_MIX, D), 0.0, 1.0),
        'rw_wr': nrm((nA, D, D), sD),
        'rw_wk': nrm((nA, D, D), sD),
        'rw_wv': nrm((nA, D, D), sD),
        'rw_wo': nrm((nA, D, D), 0.5 * sD),
        'rw_w0': unif((nA, D), -6.0, -1.0),
        'rw_w1': nrm((nA, D, LORA_DECAY), sD),
        'rw_w2': nrm((nA, LORA_DECAY, D), 0.1 * LORA_DECAY ** -0.5),
        'rw_a0': nrm((nA, D), 0.1),
        'rw_a1': nrm((nA, D, LORA_A), sD),
        'rw_a2': nrm((nA, LORA_A, D), 0.1 * LORA_A ** -0.5),
        'rw_v0': nrm((nA - 1, D), 0.1),
        'rw_v1': nrm((nA - 1, D, LORA_V), sD),
        'rw_v2': nrm((nA - 1, LORA_V, D), 0.1 * LORA_V ** -0.5),
        'rw_g1': nrm((nA, D, LORA_G), sD),
        'rw_g2': nrm((nA, LORA_G, D), LORA_G ** -0.5),
        'rw_kk': 0.85 + nrm((nA, D), 0.02),
        'rw_ka': gain((nA, D)),
        'rw_rk': nrm((nA, H, N), 0.1),
        'rw_lnx_w': gain((nA, D)),
        'rw_lnx_b': nrm((nA, D), 0.02),
        'kv_norm_g': gain((D,)),
        'w_kv': nrm((D, N_KV_PARTS * G * HD), sD),
        'cmp_pe': nrm((2, CMP_LEN, HD), 0.1),
        'cmp_w1': nrm((2, CMP_LEN * HD, HD), (CMP_LEN * HD) ** -0.5),
        'cmp_b1': nrm((2, HD), 0.02),
        'cmp_w2': nrm((2, HD, HD), HD ** -0.5),
        'b_norm_g': gain((nB, D)),
        'nsa_wq': nrm((nB, D, HB * HD + N_BRANCH * HB), sD),
        'nsa_wo': nrm((nB, HB * HD, D), 0.5 * (HB * HD) ** -0.5),
        'rel_bias': nrm((REL_BUCKETS, HB), 0.5),
        'm_norm_g': gain((DEPTH, D)),
        'mlp_up': nrm((DEPTH, D, D_FF), sD),
        'mlp_down': nrm((DEPTH, D_FF, D), 0.5 * D_FF ** -0.5),
        'final_norm_g': gain((D,)),
    }


def reference(x, a_norm_g, rw_mu, rw_wr, rw_wk, rw_wv, rw_wo, rw_w0, rw_w1, rw_w2,
              rw_a0, rw_a1, rw_a2, rw_v0, rw_v1, rw_v2, rw_g1, rw_g2, rw_kk, rw_ka, rw_rk,
              rw_lnx_w, rw_lnx_b, kv_norm_g, w_kv, cmp_pe, cmp_w1, cmp_b1, cmp_w2,
              b_norm_g, nsa_wq, nsa_wo, rel_bias, m_norm_g, mlp_up, mlp_down, final_norm_g):
    h = x
    v_first = None
    for layer in range(DEPTH):
        if layer < N_A_LAYERS:
            i = layer
            if i == 0:
                v0, v1, v2 = None, None, None
            else:
                v0, v1, v2 = rw_v0[i - 1], rw_v1[i - 1], rw_v2[i - 1]
            y, v_first = rwkv7_time_mix(
                rmsnorm(h, a_norm_g[i]), rw_mu[i], rw_wr[i], rw_wk[i], rw_wv[i], rw_wo[i],
                rw_w0[i], rw_w1[i], rw_w2[i], rw_a0[i], rw_a1[i], rw_a2[i], rw_g1[i], rw_g2[i],
                rw_kk[i], rw_ka[i], rw_rk[i], rw_lnx_w[i], rw_lnx_b[i], v_first, v0, v1, v2)
        else:
            j = layer - N_A_LAYERS
            if layer == N_A_LAYERS:
                kc, vc, ks, vs, kw, vw = nsa_shared_kv(h, kv_norm_g, w_kv, cmp_pe, cmp_w1, cmp_b1, cmp_w2)
            y = nsa_attention(rmsnorm(h, b_norm_g[j]), nsa_wq[j], nsa_wo[j], rel_bias,
                              kc, vc, ks, vs, kw, vw)
        h = h + y
        h = h + sqrelu_mlp(rmsnorm(h, m_norm_g[layer]), mlp_up[layer], mlp_down[layer])
    return rmsnorm(h, final_norm_g)
```

```cpp
#include <hip/hip_runtime.h>
#include <hip/hip_cooperative_groups.h>
#include <cstdio>
namespace cg = cooperative_groups;

#define LAS __attribute__((address_space(3)))
#define GAS __attribute__((address_space(1)))
typedef unsigned short bf16_t;
typedef short bf16x8 __attribute__((ext_vector_type(8)));
typedef short bf16x4 __attribute__((ext_vector_type(4)));
typedef float f32x4 __attribute__((ext_vector_type(4)));
typedef float f32x2v __attribute__((ext_vector_type(2)));
typedef unsigned u32x2 __attribute__((ext_vector_type(2)));
typedef unsigned u32x4 __attribute__((ext_vector_type(4)));

constexpr int T = 8192, D = 2048, DFF = 8192;
constexpr size_t MiB = 1ull << 20;
constexpr size_t OFF_RW = 0, RW_STRIDE = 40 * MiB;
constexpr size_t RW_WR = 0, RW_WK = 8 * MiB, RW_WV = 16 * MiB, RW_WO = 24 * MiB, RW_W1 = 32 * MiB, RW_A1 = 33 * MiB, RW_V1 = 34 * MiB, RW_G1 = 35 * MiB,
                 RW_W2 = 36 * MiB, RW_A2 = 37 * MiB, RW_V2 = 38 * MiB, RW_G2 = 39 * MiB;
constexpr size_t OFF_WKV = 80 * MiB, OFF_CW1 = 92 * MiB, OFF_CW2 = 96 * MiB, OFF_WQ = 97 * MiB, WQ_STRIDE = 9 * MiB, OFF_NWO = 115 * MiB,
                 OFF_C1 = 131 * MiB, OFF_C1P = 131 * MiB + 65536, OFF_MLPW = 132 * MiB, OFF_H = 196 * MiB, OFF_S = 260 * MiB;
constexpr size_t OFF_X6 = OFF_S, OFF_R = OFF_S + 192 * MiB, OFF_W = OFF_R + 64 * MiB, OFF_K = OFF_W + 64 * MiB, OFF_V = OFF_K + 64 * MiB, OFF_VF = OFF_V + 64 * MiB,
                 OFF_NA = OFF_VF + 64 * MiB, OFF_AA = OFF_NA + 64 * MiB, OFF_TW = OFF_AA + 64 * MiB, OFF_TA = OFF_TW + 4 * MiB, OFF_TV = OFF_TA + 4 * MiB, OFF_TG = OFF_TV + 4 * MiB,
                 OFF_BON = OFF_TG + 4 * MiB, OFF_RW_END = OFF_BON + 1 * MiB;
constexpr size_t OFF_U = OFF_R, OFF_Y = OFF_X6 + 64 * MiB, OFF_G = OFF_X6 + 128 * MiB, OFF_Z = OFF_X6 + 32 * MiB, OFF_XN = OFF_X6;
constexpr size_t OFF_KVN = OFF_S, OFF_HN = OFF_S + 32 * MiB, OFF_KV = OFF_S + 64 * MiB, OFF_VTS = OFF_S + 112 * MiB, OFF_VTW = OFF_S + 120 * MiB, OFF_Q = OFF_S + 128 * MiB,
                 OFF_GATES = OFF_S + 160 * MiB, OFF_ACMP = OFF_S + 162 * MiB, OFF_HID = OFF_S + 194 * MiB, OFF_KC = OFF_S + 196 * MiB, OFF_VCT = OFF_S + 197 * MiB,
                 OFF_O = OFF_S + 198 * MiB, OFF_XN2 = OFF_S + 230 * MiB, OFF_U2 = OFF_S + 262 * MiB;
constexpr size_t OFF_MLPW2 = OFF_RW_END, WS_NEED = OFF_MLPW2 + 64 * MiB;
constexpr int LDS_BYTES = 138 * 1024, LDS_DESC = 0, LDS_JOBS = 5120, LDS_CONV = 7936, LDS_WORK = 9216;

struct Params { const float* in[37]; float* out; unsigned char* ws; };

__device__ __forceinline__ int ltid() { int t = threadIdx.x; asm volatile("" : "+v"(t)); return t; }
__device__ __forceinline__ unsigned cvt_pk_bf16(float lo, float hi) { unsigned r; asm volatile("v_cvt_pk_bf16_f32 %0, %1, %2" : "=v"(r) : "v"(lo), "v"(hi)); return r; }
__device__ __forceinline__ void store_bf4(bf16_t* p, f32x4 v) { u32x2 w; w.x = cvt_pk_bf16(v[0], v[1]); w.y = cvt_pk_bf16(v[2], v[3]); *(GAS u32x2*)p = w; }
__device__ __forceinline__ float wave_sum(float v) {
#pragma unroll
    for (int o = 32; o; o >>= 1) v += __shfl_xor(v, o);
    return v;
}
template <int CTRL> __device__ __forceinline__ float dpp_f(float x) { return __int_as_float(__builtin_amdgcn_update_dpp(0, __float_as_int(x), CTRL, 0xF, 0xF, true)); }
__device__ __forceinline__ float red16(float x) { x += dpp_f<0xB1>(x); x += dpp_f<0x4E>(x); x += dpp_f<0x141>(x); x += dpp_f<0x140>(x); return x; }
__device__ __forceinline__ float xmax4(float x) {
    auto a = __builtin_amdgcn_permlane16_swap(__float_as_uint(x), __float_as_uint(x), false, false);
    x = fmaxf(__uint_as_float(a[0]), __uint_as_float(a[1]));
    auto b = __builtin_amdgcn_permlane32_swap(__float_as_uint(x), __float_as_uint(x), false, false);
    return fmaxf(__uint_as_float(b[0]), __uint_as_float(b[1]));
}
__device__ __forceinline__ float xsum4(float x) {
    auto a = __builtin_amdgcn_permlane16_swap(__float_as_uint(x), __float_as_uint(x), false, false);
    x = __uint_as_float(a[0]) + __uint_as_float(a[1]);
    auto b = __builtin_amdgcn_permlane32_swap(__float_as_uint(x), __float_as_uint(x), false, false);
    return __uint_as_float(b[0]) + __uint_as_float(b[1]);
}
__device__ __forceinline__ float sigmoidf_(float x) { return 1.f / (1.f + __expf(-x)); }
__device__ __forceinline__ float tanhf_(float x) { float e = __expf(2.f * x); return 1.f - 2.f / (e + 1.f); }
__device__ __forceinline__ void wave_fence() { __builtin_amdgcn_fence(__ATOMIC_SEQ_CST, "wavefront"); __builtin_amdgcn_wave_barrier(); }

template <class P> __device__ __forceinline__ P uptr(P x) {
    unsigned long long v = (unsigned long long)x;
    const unsigned lo = __builtin_amdgcn_readfirstlane((unsigned)v), hi = __builtin_amdgcn_readfirstlane((unsigned)(v >> 32));
    return (P)(((unsigned long long)hi << 32) | lo);
}

__device__ __forceinline__ void convT(const float* __restrict__ src, int K, int N, bf16_t* __restrict__ dst, int Kp, int Np, LAS float* tile, int& off) {
    const int tid = ltid(), nb = gridDim.x;
    const int tn = Np / 64, ntile = (Kp / 64) * tn;
    int start = ((int)blockIdx.x - (off % nb) + nb) % nb;
    off += ntile;
    const int kl0 = tid >> 4, nl0 = (tid & 15) * 4;
    f32x4 pv[2];
#define CONV_LOAD(ti_) do { const int k0_ = ((ti_) / tn) * 64, n0_ = ((ti_) % tn) * 64; _Pragma("unroll") for (int i = 0; i < 2; ++i) { \
        const int kk_ = k0_ + kl0 + 32 * i, nn_ = n0_ + nl0; pv[i] = (f32x4){0.f, 0.f, 0.f, 0.f}; \
        if (kk_ < K && nn_ < N) pv[i] = *(const GAS f32x4*)(src + (size_t)kk_ * N + nn_); } } while (0)
    if (start < ntile) CONV_LOAD(start);
    for (int ti = start; ti < ntile; ti += nb) {
        const int k0 = (ti / tn) * 64, n0 = (ti % tn) * 64;
        const f32x4 c0 = pv[0], c1 = pv[1];
        if (ti + nb < ntile) CONV_LOAD(ti + nb);
        tile[(nl0 + 0) * 65 + kl0] = c0[0]; tile[(nl0 + 1) * 65 + kl0] = c0[1]; tile[(nl0 + 2) * 65 + kl0] = c0[2]; tile[(nl0 + 3) * 65 + kl0] = c0[3];
        tile[(nl0 + 0) * 65 + kl0 + 32] = c1[0]; tile[(nl0 + 1) * 65 + kl0 + 32] = c1[1]; tile[(nl0 + 2) * 65 + kl0 + 32] = c1[2]; tile[(nl0 + 3) * 65 + kl0 + 32] = c1[3];
        __syncthreads();
        {
            const int nl = tid >> 3, k8 = (tid & 7) * 8;
            const LAS float* tp = tile + nl * 65 + k8;
            u32x4 w; w.x = cvt_pk_bf16(tp[0], tp[1]); w.y = cvt_pk_bf16(tp[2], tp[3]); w.z = cvt_pk_bf16(tp[4], tp[5]); w.w = cvt_pk_bf16(tp[6], tp[7]);
            *(GAS u32x4*)(dst + (size_t)(n0 + nl) * Kp + k0 + k8) = w;
        }
        __syncthreads();
    }
#undef CONV_LOAD
}

__device__ __forceinline__ void phase_mix(const float* __restrict__ H, const float* __restrict__ gn, const float* __restrict__ mu, bf16_t* __restrict__ X6) {
    const int wid = ltid() >> 6, lane = ltid() & 63;
    for (int row = blockIdx.x * 8 + wid; row < T; row += gridDim.x * 8) {
        const float* hp = H + (size_t)row * D;
        f32x4 x[8], xp[8];
        float ss = 0.f, ssp = 0.f;
#pragma unroll
        for (int i = 0; i < 8; ++i) { x[i] = *(const f32x4*)(hp + i * 256 + lane * 4); ss += x[i][0] * x[i][0] + x[i][1] * x[i][1] + x[i][2] * x[i][2] + x[i][3] * x[i][3]; }
        if (row > 0) {
#pragma unroll
            for (int i = 0; i < 8; ++i) { xp[i] = *(const f32x4*)(hp - D + i * 256 + lane * 4); ssp += xp[i][0] * xp[i][0] + xp[i][1] * xp[i][1] + xp[i][2] * xp[i][2] + xp[i][3] * xp[i][3]; }
        } else {
#pragma unroll
            for (int i = 0; i < 8; ++i) xp[i] = (f32x4){0.f, 0.f, 0.f, 0.f};
        }
        ss = wave_sum(ss); ssp = wave_sum(ssp);
        const float rs = rsqrtf(ss * (1.f / D) + 1e-6f), rsp = row > 0 ? rsqrtf(ssp * (1.f / D) + 1e-6f) : 0.f;
#pragma unroll
        for (int i = 0; i < 8; ++i) {
            const int col = i * 256 + lane * 4;
            const f32x4 g4 = *(const f32x4*)(gn + col);
            const f32x4 xn = x[i] * rs * g4, dx = xp[i] * rsp * g4 - xn;
#pragma unroll
            for (int j = 0; j < 6; ++j) {
                const f32x4 m4 = *(const f32x4*)(mu + j * D + col);
                store_bf4(X6 + (size_t)j * T * D + (size_t)row * D + col, xn + dx * m4);
            }
        }
    }
}
__device__ __forceinline__ void phase_norm(const float* __restrict__ H, const float* __restrict__ g1, bf16_t* __restrict__ o1, const float* __restrict__ g2, bf16_t* __restrict__ o2, float* __restrict__ fout) {
    const int wid = ltid() >> 6, lane = ltid() & 63;
    for (int row = blockIdx.x * 8 + wid; row < T; row += gridDim.x * 8) {
        const float* hp = H + (size_t)row * D;
        f32x4 x[8]; float ss = 0.f;
#pragma unroll
        for (int i = 0; i < 8; ++i) { x[i] = *(const f32x4*)(hp + i * 256 + lane * 4); ss += x[i][0] * x[i][0] + x[i][1] * x[i][1] + x[i][2] * x[i][2] + x[i][3] * x[i][3]; }
        ss = wave_sum(ss);
        const float rs = rsqrtf(ss * (1.f / D) + 1e-6f);
#pragma unroll
        for (int i = 0; i < 8; ++i) {
            const int col = i * 256 + lane * 4;
            const f32x4 y = x[i] * rs * *(const f32x4*)(g1 + col);
            if (fout) *(f32x4*)(fout + (size_t)row * D + col) = y;
            else store_bf4(o1 + (size_t)row * D + col, y);
            if (g2) store_bf4(o2 + (size_t)row * D + col, x[i] * rs * *(const f32x4*)(g2 + col));
        }
    }
}
__device__ __forceinline__ void phase_prep(const float* __restrict__ R, float* __restrict__ Kb, float* __restrict__ AA, float* __restrict__ NA, float* __restrict__ BON,
                           const float* __restrict__ k_k, const float* __restrict__ k_a, const float* __restrict__ r_k) {
    const int wid = ltid() >> 6, lane = ltid() & 63;
    for (int row = blockIdx.x * 8 + wid; row < T; row += gridDim.x * 8) {
#pragma unroll 2
        for (int i = 0; i < 8; ++i) {
            const int col = i * 256 + lane * 4; const size_t o = (size_t)row * D + col;
            const f32x4 k = *(const f32x4*)(Kb + o), a = *(const f32x4*)(AA + o), r = *(const f32x4*)(R + o);
            f32x4 kk = k * *(const f32x4*)(k_k + col);
            float ss = red16(kk[0] * kk[0] + kk[1] * kk[1] + kk[2] * kk[2] + kk[3] * kk[3]);
            kk = kk * rsqrtf(fmaxf(ss, 1e-24f));
            const f32x4 kp = k * (1.f + (a - 1.f) * *(const f32x4*)(k_a + col));
            const f32x4 rk = r * kp * *(const f32x4*)(r_k + col);
            const float bon = red16(rk[0] + rk[1] + rk[2] + rk[3]);
            *(f32x4*)(Kb + o) = kp; *(f32x4*)(NA + o) = -kk; *(f32x4*)(AA + o) = kk * a;
            if ((lane & 15) == 0) BON[(size_t)row * 32 + i * 4 + (lane >> 4)] = bon;
        }
    }
}
__device__ __forceinline__ void phase_post(const float* __restrict__ Y, const float* __restrict__ BON, const float* __restrict__ V, const float* __restrict__ G,
                           const float* __restrict__ lw, const float* __restrict__ lb, bf16_t* __restrict__ Z) {
    const int wid = ltid() >> 6, lane = ltid() & 63;
    for (int row = blockIdx.x * 8 + wid; row < T; row += gridDim.x * 8) {
#pragma unroll 2
        for (int i = 0; i < 8; ++i) {
            const int col = i * 256 + lane * 4; const size_t o = (size_t)row * D + col;
            const f32x4 y = *(const f32x4*)(Y + o);
            const float mean = red16(y[0] + y[1] + y[2] + y[3]) * (1.f / 64.f);
            const f32x4 d = y - mean;
            const float var = red16(d[0] * d[0] + d[1] * d[1] + d[2] * d[2] + d[3] * d[3]) * (1.f / 64.f);
            const f32x4 yn = d * rsqrtf(var + 64e-5f) * *(const f32x4*)(lw + col) + *(const f32x4*)(lb + col);
            const float bon = BON[(size_t)row * 32 + i * 4 + (lane >> 4)];
            store_bf4(Z + o, (yn + bon * *(const f32x4*)(V + o)) * *(const f32x4*)(G + o));
        }
    }
}

struct Conv { const float* src; bf16_t* dst; int K, N, Kp, Np; };
__device__ __forceinline__ void conv_worker(const LAS Conv* cv, int nconv, int wg, int nw, LAS unsigned short* tl, int lane) {
    const int l15 = lane & 15, q = lane >> 4;
    int off = 0;
    for (int ci = 0; ci < nconv; ++ci) {
        const float* __restrict__ src = uptr(cv[ci].src); bf16_t* __restrict__ dst = uptr(cv[ci].dst);
        const int K = __builtin_amdgcn_readfirstlane(cv[ci].K), N = __builtin_amdgcn_readfirstlane(cv[ci].N), Kp = __builtin_amdgcn_readfirstlane(cv[ci].Kp), Np = __builtin_amdgcn_readfirstlane(cv[ci].Np);
        const int tn = Np / 64, ntile = (Kp / 32) * tn;
        const int start = (wg - (off % nw) + nw) % nw;
        off += ntile;
        f32x4 pv[8];
#define CW_LOAD(ti_) do { const int k0_ = ((ti_) / tn) * 32, n0_ = ((ti_) % tn) * 64; _Pragma("unroll") for (int i = 0; i < 8; ++i) { \
            const int kk_ = k0_ + q + 4 * i, nn_ = n0_ + l15 * 4; pv[i] = (f32x4){0.f, 0.f, 0.f, 0.f}; \
            if (kk_ < K && nn_ < N) pv[i] = *(const GAS f32x4*)(src + (size_t)kk_ * N + nn_); } } while (0)
        if (start < ntile) CW_LOAD(start);
        for (int ti = start; ti < ntile; ti += nw) {
            const int k0 = (ti / tn) * 32, n0 = (ti % tn) * 64;
            f32x4 c[8];
#pragma unroll
            for (int i = 0; i < 8; ++i) c[i] = pv[i];
            if (ti + nw < ntile) CW_LOAD(ti + nw);
#pragma unroll
            for (int i = 0; i < 8; ++i) {
                const unsigned p01 = cvt_pk_bf16(c[i][0], c[i][1]), p23 = cvt_pk_bf16(c[i][2], c[i][3]);
                const int kl = q + 4 * i;
                tl[(l15 * 4 + 0) * 34 + kl] = (unsigned short)(p01 & 0xffffu); tl[(l15 * 4 + 1) * 34 + kl] = (unsigned short)(p01 >> 16);
                tl[(l15 * 4 + 2) * 34 + kl] = (unsigned short)(p23 & 0xffffu); tl[(l15 * 4 + 3) * 34 + kl] = (unsigned short)(p23 >> 16);
            }
            wave_fence();
            const LAS unsigned* rp = (const LAS unsigned*)(tl + lane * 34);
#pragma unroll
            for (int j = 0; j < 4; ++j) { u32x4 w; w.x = rp[4 * j + 0]; w.y = rp[4 * j + 1]; w.z = rp[4 * j + 2]; w.w = rp[4 * j + 3]; *(GAS u32x4*)(dst + (size_t)(n0 + lane) * Kp + k0 + 8 * j) = w; }
            wave_fence();
        }
#undef CW_LOAD
    }
}

__device__ __forceinline__ void phase_scan(const float* __restrict__ R, const float* __restrict__ W, const float* __restrict__ Kb, const float* __restrict__ V,
                           const float* __restrict__ NA, const float* __restrict__ NB, float* __restrict__ Y, LAS unsigned char* lds, const LAS Conv* cv, int nconv) {
    const int wid = ltid() >> 6, lane = ltid() & 63, nb = gridDim.x;
    constexpr int CH = 16, BUF_F = CH * 320 + 64;
    if ((wid & 3) >= 2) {
        const int widx = (wid >> 2) * 2 + (wid & 1);
        conv_worker(cv, nconv, (int)blockIdx.x * 4 + widx, nb * 4, (LAS unsigned short*)(lds + 2 * (2 * BUF_F + 64) * 4) + widx * (64 * 34 + 32), lane);
        return;
    }
    if (wid >= 2) return;
    LAS float* wbase = (LAS float*)lds + wid * (2 * BUF_F + 64);
    LAS float* ybuf = wbase + 2 * BUF_F;
    const int rl = lane >> 4, cl = lane & 15;
    for (int u = (int)blockIdx.x + nb * wid; u < 512; u += nb * 2) {
        int head, rowgrp;
        if (nb == 256) { const int xcd = blockIdx.x & 7, slot = (blockIdx.x >> 3) + 32 * wid; head = xcd * 4 + (slot >> 4); rowgrp = slot & 15; }
        else { head = u >> 4; rowgrp = u & 15; }
        const int cbase = head * 64, rowbase = rowgrp * 4;
        const GAS float* arr[5] = {(const GAS float*)W, (const GAS float*)Kb, (const GAS float*)NA, (const GAS float*)NB, (const GAS float*)R};
        const GAS float* Vg = (const GAS float*)V; GAS float* Yg = (GAS float*)Y;
        f32x4 pre[20]; float prev;
#define SCAN_LOAD(t0) do { _Pragma("unroll") for (int a = 0; a < 5; ++a) _Pragma("unroll") for (int i = 0; i < 4; ++i) \
            pre[a * 4 + i] = *(const GAS f32x4*)(arr[a] + (size_t)((t0) + 4 * i + rl) * D + cbase + cl * 4); \
            prev = Vg[(size_t)((t0) + (lane >> 2)) * D + cbase + rowbase + (lane & 3)]; } while (0)
#define SCAN_STORE(buf) do { _Pragma("unroll") for (int a = 0; a < 5; ++a) _Pragma("unroll") for (int i = 0; i < 4; ++i) \
            *(LAS f32x4*)((buf) + ((4 * i + rl) * 5 + a) * 64 + cl * 4) = pre[a * 4 + i]; (buf)[CH * 320 + lane] = prev; } while (0)
        SCAN_LOAD(0);
        SCAN_STORE(wbase);
        wave_fence();
        f32x4 S = {0.f, 0.f, 0.f, 0.f};
        for (int c = 0; c < T / CH; ++c) {
            LAS float* cur = wbase + (c & 1) * BUF_F;
            LAS float* nxt = wbase + ((c + 1) & 1) * BUF_F;
            const bool more = (c + 1) < T / CH;
            if (more) SCAN_LOAD((c + 1) * CH);
            float yacc = 0.f;
            f32x4 w4, k4, a4, b4, r4; float v;
#define SCAN_RD(s_) do { const LAS float* sp = cur + (s_) * 320 + cl * 4; w4 = *(const LAS f32x4*)(sp); k4 = *(const LAS f32x4*)(sp + 64); a4 = *(const LAS f32x4*)(sp + 128); \
                b4 = *(const LAS f32x4*)(sp + 192); r4 = *(const LAS f32x4*)(sp + 256); v = cur[CH * 320 + (s_) * 4 + rl]; } while (0)
            SCAN_RD(0);
            f32x4 pr = r4;
#pragma unroll
            for (int s = 0; s < CH; ++s) {
                const f32x4 cw = w4, ck = k4, ca = a4, cb = b4, cr = r4; const float cv = v;
                if (s + 1 < CH) SCAN_RD(s + 1);
                __builtin_amdgcn_sched_barrier(0);
                f32x2v ta = (f32x2v){S[0], S[1]} * (f32x2v){ca[0], ca[1]}; ta = (f32x2v){S[2], S[3]} * (f32x2v){ca[2], ca[3]} + ta;
                f32x2v ty = (f32x2v){S[0], S[1]} * (f32x2v){pr[0], pr[1]}; ty = (f32x2v){S[2], S[3]} * (f32x2v){pr[2], pr[3]} + ty;
                float sa = ta[0] + ta[1];
                float y = ty[0] + ty[1];
                const f32x4 cc = S * cw + cv * ck;
                sa += dpp_f<0xB1>(sa); y += dpp_f<0xB1>(y);
                sa += dpp_f<0x4E>(sa); y += dpp_f<0x4E>(y);
                sa += dpp_f<0x141>(sa); y += dpp_f<0x141>(y);
                sa += dpp_f<0x140>(sa); y += dpp_f<0x140>(y);
                S = sa * cb + cc;
                if (s > 0) yacc = (cl == s - 1) ? y : yacc;
                pr = cr;
            }
            {
                float y = S[0] * pr[0] + S[1] * pr[1] + S[2] * pr[2] + S[3] * pr[3];
                y = red16(y);
                yacc = (cl == CH - 1) ? y : yacc;
            }
#undef SCAN_RD
            Yg[(size_t)(c * CH + cl) * D + cbase + rowbase + rl] = yacc;
            if (more) SCAN_STORE(nxt);
            wave_fence();
        }
#undef SCAN_LOAD
#undef SCAN_STORE
    }
}

enum { EP_F32 = 0, EP_BF16, EP_TANH, EP_SIGM, EP_RELU2, EP_RESID, EP_DECAY, EP_SIGB, EP_VMIX, EP_Q, EP_GELU };
struct Job { const bf16_t* A; const bf16_t* Bt; void* out; const float* aux; const float* aux2; int nM, nN, ldc, mode, ustart, pad0; };
struct Unit { int pm, pn, job; };
constexpr int BM = 256, BK = 64, HALF = 128, HTB = HALF * BK * 2;
__device__ __forceinline__ int lds_byte(int r, int c) { const int st = (r >> 4) * 2 + (c >> 5), rr = r & 15, cc = c & 31, ob = rr * 64 + cc * 2; return st * 1024 + (ob ^ (((ob >> 9) & 1) << 5)); }
__device__ __forceinline__ void stage_rc(int b, int& R, int& C) { const int st = b / 1024, sb = b % 1024, swz = sb ^ (((sb >> 9) & 1) << 5); R = (st >> 1) * 16 + swz / 64; C = (st & 1) * 32 + (swz % 64) / 2; }

__device__ __forceinline__ bool next_unit(const LAS Job* jobs, int nj, int total, int i, Unit& u) {
    const long L = (long)i * gridDim.x + blockIdx.x;
    if (L >= total) return false;
    int j = 0;
    for (int q = 1; q < nj; ++q) if ((int)L >= jobs[q].ustart) j = q;
    const int nM = jobs[j].nM, nN = jobs[j].nN, nwg = nM * nN;
    int wgid = (int)L - jobs[j].ustart;
    { const int q = nwg / 8, r = nwg % 8, xcd = wgid % 8, off = wgid / 8; wgid = (xcd < r ? xcd * (q + 1) : r * (q + 1) + (xcd - r) * q) + off; }
    const int nig = 8 * nN, gid = wgid / nig, fm = gid * 8, gsz = (nM - fm) < 8 ? (nM - fm) : 8;
    u.pm = __builtin_amdgcn_readfirstlane(fm + ((wgid % nig) % gsz));
    u.pn = __builtin_amdgcn_readfirstlane((wgid % nig) / gsz);
    u.job = __builtin_amdgcn_readfirstlane(j);
    return true;
}

template <int MODE>
__device__ __forceinline__ void epi_t(const f32x4 (&acc)[2][2][4][2], void* outp, int ldc, const float* aux, const float* aux2, int pm, int pn, int wr, int wc, int fr, int fq) {
    const int row0 = pm * BM + wr * 64 + fr, col0 = pn * BM + wc * 32 + 4 * fq;
#pragma unroll
    for (int ai = 0; ai < 2; ++ai)
#pragma unroll
        for (int m = 0; m < 4; ++m) {
            const size_t row = (size_t)(row0 + ai * HALF + m * 16);
#pragma unroll
            for (int bj = 0; bj < 2; ++bj)
#pragma unroll
                for (int n = 0; n < 2; ++n) {
                    const int col = col0 + bj * HALF + n * 16;
                    f32x4 v = acc[ai][bj][m][n];
                    const size_t o = row * (size_t)ldc + col;
                    if constexpr (MODE == EP_F32) { *(f32x4*)((float*)outp + o) = v; }
                    else if constexpr (MODE == EP_BF16) { store_bf4((bf16_t*)outp + o, v); }
                    else if constexpr (MODE == EP_TANH) { v[0] = tanhf_(v[0]); v[1] = tanhf_(v[1]); v[2] = tanhf_(v[2]); v[3] = tanhf_(v[3]); store_bf4((bf16_t*)outp + o, v); }
                    else if constexpr (MODE == EP_SIGM) { v[0] = sigmoidf_(v[0]); v[1] = sigmoidf_(v[1]); v[2] = sigmoidf_(v[2]); v[3] = sigmoidf_(v[3]); store_bf4((bf16_t*)outp + o, v); }
                    else if constexpr (MODE == EP_RELU2) { v[0] = fmaxf(v[0], 0.f); v[1] = fmaxf(v[1], 0.f); v[2] = fmaxf(v[2], 0.f); v[3] = fmaxf(v[3], 0.f); store_bf4((bf16_t*)outp + o, v * v); }
                    else if constexpr (MODE == EP_RESID) { f32x4* hp = (f32x4*)((float*)outp + o); *hp = *hp + v; }
                    else if constexpr (MODE == EP_DECAY) {
                        const f32x4 x = v + *(const f32x4*)(aux + col);
#pragma unroll
                        for (int j = 0; j < 4; ++j) { const float z = -x[j]; const float sp = fmaxf(z, 0.f) + log1pf(__expf(-fabsf(z))); v[j] = __expf(-__expf(-sp - 0.5f)); }
                        *(f32x4*)((float*)outp + o) = v;
                    }
                    else if constexpr (MODE == EP_SIGB) {
                        const f32x4 x = v + *(const f32x4*)(aux + col);
                        v[0] = sigmoidf_(x[0]); v[1] = sigmoidf_(x[1]); v[2] = sigmoidf_(x[2]); v[3] = sigmoidf_(x[3]);
                        *(f32x4*)((float*)outp + o) = v;
                    }
                    else if constexpr (MODE == EP_VMIX) {
                        const f32x4 x = v + *(const f32x4*)(aux + col);
                        const f32x4 vf = *(const f32x4*)(aux2 + o); f32x4 vv = *(const f32x4*)((float*)outp + o);
#pragma unroll
                        for (int j = 0; j < 4; ++j) vv[j] = vv[j] + (vf[j] - vv[j]) * sigmoidf_(x[j]);
                        *(f32x4*)((float*)outp + o) = vv;
                    }
                    else if constexpr (MODE == EP_Q) {
                        if (col < 2048) { store_bf4((bf16_t*)outp + row * 2048 + col, v * 0.08838834764831845f); }
                        else if (col < 2096) { v[0] = sigmoidf_(v[0]); v[1] = sigmoidf_(v[1]); v[2] = sigmoidf_(v[2]); v[3] = sigmoidf_(v[3]); *(f32x4*)((float*)aux + row * 48 + (col - 2048)) = v; }
                    }
                    else if constexpr (MODE == EP_GELU) {
                        const f32x4 x = v + *(const f32x4*)(aux + col);
#pragma unroll
                        for (int j = 0; j < 4; ++j) { const float xx = x[j]; v[j] = 0.5f * xx * (1.f + tanhf_(0.7978845608028654f * (xx + 0.044715f * xx * xx * xx))); }
                        store_bf4((bf16_t*)outp + o, v);
                    }
                }
        }
}
__device__ __forceinline__ void epilogue(const f32x4 (&acc)[2][2][4][2], const LAS Job* jb, int pm, int pn, int wr, int wc, int fr, int fq) {
    void* outp = jb->out; const int ldc = jb->ldc, mode = __builtin_amdgcn_readfirstlane(jb->mode); const float* aux = jb->aux; const float* aux2 = jb->aux2;
    switch (mode) {
        case EP_F32: epi_t<EP_F32>(acc, outp, ldc, aux, aux2, pm, pn, wr, wc, fr, fq); break;
        case EP_BF16: epi_t<EP_BF16>(acc, outp, ldc, aux, aux2, pm, pn, wr, wc, fr, fq); break;
        case EP_TANH: epi_t<EP_TANH>(acc, outp, ldc, aux, aux2, pm, pn, wr, wc, fr, fq); break;
        case EP_SIGM: epi_t<EP_SIGM>(acc, outp, ldc, aux, aux2, pm, pn, wr, wc, fr, fq); break;
        case EP_RELU2: epi_t<EP_RELU2>(acc, outp, ldc, aux, aux2, pm, pn, wr, wc, fr, fq); break;
        case EP_RESID: epi_t<EP_RESID>(acc, outp, ldc, aux, aux2, pm, pn, wr, wc, fr, fq); break;
        case EP_DECAY: epi_t<EP_DECAY>(acc, outp, ldc, aux, aux2, pm, pn, wr, wc, fr, fq); break;
        case EP_SIGB: epi_t<EP_SIGB>(acc, outp, ldc, aux, aux2, pm, pn, wr, wc, fr, fq); break;
        case EP_VMIX: epi_t<EP_VMIX>(acc, outp, ldc, aux, aux2, pm, pn, wr, wc, fr, fq); break;
        case EP_Q: epi_t<EP_Q>(acc, outp, ldc, aux, aux2, pm, pn, wr, wc, fr, fq); break;
        default: epi_t<EP_GELU>(acc, outp, ldc, aux, aux2, pm, pn, wr, wc, fr, fq); break;
    }
}

__device__ __forceinline__ void gemm_phase(LAS unsigned char* lds, const LAS Job* jobs, int nj, int total, int K, int lda, int ldb) {
    const int tid = ltid(), wid = __builtin_amdgcn_readfirstlane(tid >> 6), lane = tid & 63, wr = wid >> 2, wc = wid & 3, fr = lane & 15, fq = lane >> 4;
    const int nt = K / BK;
    unsigned voffA[2], voffB[2];
#pragma unroll
    for (int i = 0; i < 2; ++i) { int R, C; stage_rc(tid * 16 + i * 8192, R, C); voffA[i] = (unsigned)(R * lda + C) * 2u; voffB[i] = (unsigned)(R * ldb + C) * 2u; }
    const size_t kstep = (size_t)(BK * 2);
    const size_t hstepA = (size_t)HALF * lda * 2, hstepB = (size_t)HALF * ldb * 2;
    const size_t tstepA = 2 * hstepA, tstepB = 2 * hstepB;
    const unsigned ldsw = (unsigned)wid * 1024u;
    const int aoff = lds_byte(wr * 64 + fr, fq * 8), boff = lds_byte(wc * 32 + fr, fq * 8);
#define PG8_SA(b, h) (((b) * 2 + (h)) * HTB)
#define PG8_SB(b, h) ((4 + (b) * 2 + (h)) * HTB)
#define PG8_STAGE(bufoff, gbase, voff) do { _Pragma("unroll") for (int _i = 0; _i < 2; ++_i) \
        __builtin_amdgcn_global_load_lds((const unsigned*)((const char*)(gbase) + (voff)[_i]), (LAS unsigned*)(lds + (bufoff) + ldsw + _i * 8192), 16, 0, 0); } while (0)
#define PG8_LDA(dst, b, h) do { _Pragma("unroll") for (int m = 0; m < 4; ++m) _Pragma("unroll") for (int k = 0; k < 2; ++k) dst[m][k] = *(const LAS bf16x8*)(lds + PG8_SA(b, h) + aoff + m * 2048 + k * 1024); } while (0)
#define PG8_LDB(dst, b, h) do { _Pragma("unroll") for (int n = 0; n < 2; ++n) _Pragma("unroll") for (int k = 0; k < 2; ++k) dst[n][k] = *(const LAS bf16x8*)(lds + PG8_SB(b, h) + boff + n * 2048 + k * 1024); } while (0)
#define PG8_MMA(ai, bj, At, Bt) do { __builtin_amdgcn_s_setprio(1); _Pragma("unroll") for (int m = 0; m < 4; ++m) _Pragma("unroll") for (int n = 0; n < 2; ++n) _Pragma("unroll") for (int k = 0; k < 2; ++k) \
        acc[ai][bj][m][n] = __builtin_amdgcn_mfma_f32_16x16x32_bf16(Bt[n][k], At[m][k], acc[ai][bj][m][n], 0, 0, 0); __builtin_amdgcn_s_setprio(0); } while (0)
#define PG8_WAIT_V(n) asm volatile("s_waitcnt vmcnt(" #n ")" ::: "memory")
#define PG8_WAIT_L(n) asm volatile("s_waitcnt lgkmcnt(" #n ")" ::: "memory")
#define PG8_BAR __builtin_amdgcn_s_barrier()
#define PG8_SCHED __builtin_amdgcn_sched_barrier(0)
    Unit cur, nxt; int ui = 0;
    if (!next_unit(jobs, nj, total, 0, cur)) return;
    f32x4 acc[2][2][4][2];
#pragma unroll
    for (int a = 0; a < 2; ++a)
#pragma unroll
        for (int b = 0; b < 2; ++b)
#pragma unroll
            for (int m = 0; m < 4; ++m)
#pragma unroll
                for (int n = 0; n < 2; ++n) acc[a][b][m][n] = (f32x4){0.f, 0.f, 0.f, 0.f};
    bf16x8 At[4][2], B0[2][2], B1[2][2];
    const char* cA = (const char*)jobs[cur.job].A + (size_t)cur.pm * tstepA; const char* cB = (const char*)jobs[cur.job].Bt + (size_t)cur.pn * tstepB;
    PG8_STAGE(PG8_SB(0, 0), cB, voffB); PG8_STAGE(PG8_SA(0, 0), cA, voffA); PG8_STAGE(PG8_SB(0, 1), cB + hstepB, voffB); PG8_STAGE(PG8_SA(0, 1), cA + hstepA, voffA);
    if (wr == 1) PG8_BAR;
    PG8_WAIT_V(4); PG8_BAR;
    PG8_STAGE(PG8_SB(1, 0), cB + kstep, voffB); PG8_STAGE(PG8_SA(1, 0), cA + kstep, voffA); PG8_STAGE(PG8_SB(1, 1), cB + hstepB + kstep, voffB);
    PG8_WAIT_V(6); PG8_BAR;
    for (;;) {
        const bool has_next = next_unit(jobs, nj, total, ui + 1, nxt);
        const char* nA = has_next ? (const char*)jobs[nxt.job].A + (size_t)nxt.pm * tstepA : cA; const char* nB = has_next ? (const char*)jobs[nxt.job].Bt + (size_t)nxt.pn * tstepB : cB;
        for (int t = 0; t < nt; t += 2) {
            const bool last = (t == nt - 2);
            const char* a1 = cA + (size_t)(t + 1) * kstep;
            const char* a2 = last ? nA : cA + (size_t)(t + 2) * kstep; const char* b2 = last ? nB : cB + (size_t)(t + 2) * kstep;
            const char* a3 = a2 + kstep; const char* b3 = b2 + kstep;
            PG8_LDB(B0, 0, 0); PG8_SCHED; PG8_LDA(At, 0, 0); PG8_STAGE(PG8_SA(1, 1), a1 + hstepA, voffA);
            PG8_WAIT_L(8); PG8_BAR; PG8_WAIT_L(0); PG8_MMA(0, 0, At, B0); PG8_BAR; PG8_SCHED;
            PG8_LDB(B1, 0, 1); PG8_STAGE(PG8_SB(0, 0), b2, voffB);
            PG8_BAR; PG8_WAIT_L(0); PG8_MMA(0, 1, At, B1); PG8_BAR;
            PG8_LDA(At, 0, 1); PG8_STAGE(PG8_SA(0, 0), a2, voffA);
            PG8_BAR; PG8_WAIT_L(0); PG8_MMA(1, 0, At, B0); PG8_BAR; PG8_SCHED;
            PG8_STAGE(PG8_SB(0, 1), b2 + hstepB, voffB);
            PG8_WAIT_V(6); PG8_BAR; PG8_MMA(1, 1, At, B1); PG8_BAR;
            PG8_LDB(B0, 1, 0); PG8_SCHED; PG8_LDA(At, 1, 0); PG8_STAGE(PG8_SA(0, 1), a2 + hstepA, voffA);
            PG8_WAIT_L(8); PG8_BAR; PG8_WAIT_L(0); PG8_MMA(0, 0, At, B0); PG8_BAR; PG8_SCHED;
            PG8_LDB(B1, 1, 1); PG8_STAGE(PG8_SB(1, 0), b3, voffB);
            PG8_BAR; PG8_WAIT_L(0); PG8_MMA(0, 1, At, B1); PG8_BAR;
            PG8_LDA(At, 1, 1); PG8_STAGE(PG8_SA(1, 0), a3, voffA);
            PG8_BAR; PG8_WAIT_L(0); PG8_MMA(1, 0, At, B0); PG8_BAR; PG8_SCHED;
            PG8_STAGE(PG8_SB(1, 1), b3 + hstepB, voffB);
            PG8_WAIT_V(6); PG8_BAR; PG8_MMA(1, 1, At, B1); PG8_BAR;
        }
        epilogue(acc, jobs + cur.job, cur.pm, cur.pn, wr, wc, fr, fq);
        if (!has_next) break;
#pragma unroll
        for (int a = 0; a < 2; ++a)
#pragma unroll
            for (int b = 0; b < 2; ++b)
#pragma unroll
                for (int m = 0; m < 4; ++m)
#pragma unroll
                    for (int n = 0; n < 2; ++n) acc[a][b][m][n] = (f32x4){0.f, 0.f, 0.f, 0.f};
        cur = nxt; cA = nA; cB = nB; ++ui;
    }
    PG8_WAIT_V(0);
    if (wr == 0) PG8_BAR;
    PG8_BAR;
#undef PG8_SA
#undef PG8_SB
#undef PG8_STAGE
#undef PG8_LDA
#undef PG8_LDB
#undef PG8_MMA
#undef PG8_WAIT_V
#undef PG8_WAIT_L
#undef PG8_BAR
#undef PG8_SCHED
}

__device__ __forceinline__ int t5_bucket_dev(int n) { if (n < 16) return n; int b = 16 + (int)(logf((float)n * 0.0625f) / 2.0794415416798357f * 16.0f); return b > 31 ? 31 : b; }

constexpr int KROW = 272, VROW = 144, KTILE_B = 64 * KROW, VTILE_B = 128 * VROW;
template <int BR, int NT>
__device__ __forceinline__ void flash_chunk(const bool FAST, const bf16x8 (&qf)[NT][4], float (&m)[NT], float (&l)[NT], f32x4 (&O)[NT][8], const LAS unsigned char* kl, const LAS unsigned char* vl,
                                            const int (&t)[NT], int key0, const LAS float* mylut, const bool (&selbit)[NT], float inv_l, volatile LAS float* myimp, int lane) {
    const int tok = lane & 15, q = lane >> 4;
    f32x4 S[NT][4];
#pragma unroll
    for (int mt = 0; mt < 4; ++mt) {
#pragma unroll
        for (int nt = 0; nt < NT; ++nt) S[nt][mt] = (f32x4){0.f, 0.f, 0.f, 0.f};
        const LAS unsigned char* kr = kl + (mt * 16 + tok) * KROW + q * 16;
#pragma unroll
        for (int kk = 0; kk < 4; ++kk) {
            const bf16x8 a = *(const LAS bf16x8*)(kr + kk * 64);
#pragma unroll
            for (int nt = 0; nt < NT; ++nt) S[nt][mt] = __builtin_amdgcn_mfma_f32_16x16x32_bf16(a, qf[nt][kk], S[nt][mt], 0, 0, 0);
        }
    }
#pragma unroll
    for (int nt = 0; nt < NT; ++nt) {
        float mx = -1e30f;
        if (FAST) {
            const float cbias = mylut[128];
#pragma unroll
            for (int mt = 0; mt < 4; ++mt)
#pragma unroll
                for (int j = 0; j < 4; ++j) { const float s = S[nt][mt][j] + cbias; S[nt][mt][j] = s; mx = fmaxf(mx, s); }
            if (BR == 2 && !selbit[nt]) mx = -1e30f;
        } else {
#pragma unroll
            for (int mt = 0; mt < 4; ++mt)
#pragma unroll
                for (int j = 0; j < 4; ++j) {
                    const int kidx = mt * 16 + q * 4 + j; int dist; bool v;
                    if (BR <= 1) { dist = t[nt] - (16 * (key0 + kidx) + 31); v = dist >= 0; }
                    else if (BR == 2) { dist = t[nt] - (key0 + kidx); v = (dist >= 0) && selbit[nt]; }
                    else { dist = t[nt] - (key0 + kidx); v = (dist >= 0) && (dist < 512); }
                    const int di = dist < 0 ? 0 : (dist > 128 ? 128 : dist);
                    float s = S[nt][mt][j] + mylut[di];
                    s = v ? s : -1e30f; S[nt][mt][j] = s; mx = fmaxf(mx, s);
                }
        }
        float mnew, alpha;
        if (BR == 1) { mnew = m[nt]; alpha = 1.f; }
        else { mx = xmax4(mx); mnew = fmaxf(m[nt], mx); alpha = __expf(m[nt] - mnew); }
        float rs = 0.f;
        if (FAST) {
            const bool v = (BR != 2) || selbit[nt];
#pragma unroll
            for (int mt = 0; mt < 4; ++mt)
#pragma unroll
                for (int j = 0; j < 4; ++j) { const float p = v ? __expf(S[nt][mt][j] - mnew) : 0.f; S[nt][mt][j] = p; rs += p; }
        } else {
#pragma unroll
            for (int mt = 0; mt < 4; ++mt)
#pragma unroll
                for (int j = 0; j < 4; ++j) { const float s = S[nt][mt][j]; const float p = (s > -1e29f) ? __expf(s - mnew) : 0.f; S[nt][mt][j] = p; rs += p; }
        }
        rs = xsum4(rs);
        l[nt] = l[nt] * alpha + rs; m[nt] = mnew;
        if (BR >= 2) {
            if (__ballot(alpha != 1.f) != 0ull) {
#pragma unroll
                for (int dt = 0; dt < 8; ++dt) O[nt][dt] = O[nt][dt] * alpha;
            }
        }
    }
    if (BR == 0) return;
    if (BR == 1) {
        const int u0 = tok * 132 + (key0 >> 2) + q;
#pragma unroll
        for (int mt = 0; mt < 4; ++mt) { const float s4 = (S[0][mt][0] + S[0][mt][1] + S[0][mt][2] + S[0][mt][3]) * inv_l; myimp[u0 + mt * 4] = myimp[u0 + mt * 4] + s4; }
        wave_fence();
#pragma unroll
        for (int mt = 0; mt < 4; ++mt) { const float p3 = S[0][mt][3] * inv_l; myimp[u0 + mt * 4 + 1] = myimp[u0 + mt * 4 + 1] + p3; }
        wave_fence();
    }
#pragma unroll
    for (int i = 0; i < 2; ++i) {
        union { u32x4 u; bf16x8 b; } pb[NT];
#pragma unroll
        for (int nt = 0; nt < NT; ++nt) {
            pb[nt].u.x = cvt_pk_bf16(S[nt][2 * i][0], S[nt][2 * i][1]); pb[nt].u.y = cvt_pk_bf16(S[nt][2 * i][2], S[nt][2 * i][3]);
            pb[nt].u.z = cvt_pk_bf16(S[nt][2 * i + 1][0], S[nt][2 * i + 1][1]); pb[nt].u.w = cvt_pk_bf16(S[nt][2 * i + 1][2], S[nt][2 * i + 1][3]);
        }
#pragma unroll
        for (int dt = 0; dt < 8; ++dt) {
            const LAS unsigned char* vr = vl + (dt * 16 + tok) * VROW + (32 * i + 4 * q) * 2;
            union { struct { u32x2 lo, hi; } s; bf16x8 b; } va;
            va.s.lo = *(const LAS u32x2*)vr; va.s.hi = *(const LAS u32x2*)(vr + 32);
#pragma unroll
            for (int nt = 0; nt < NT; ++nt) O[nt][dt] = __builtin_amdgcn_mfma_f32_16x16x32_bf16(va.b, pb[nt].b, O[nt][dt], 0, 0, 0);
        }
    }
}
__device__ __forceinline__ void kv_load(u32x4 (&r)[4], const bf16_t* __restrict__ kb, int kstride, const bf16_t* __restrict__ vb, int vtstride, bool needv, int tid) {
#pragma unroll
    for (int j = 0; j < 2; ++j) { const unsigned p = (unsigned)tid + 512u * j; const unsigned off = (p >> 4) * (unsigned)kstride + (p & 15u) * 8u; r[j] = *(const GAS u32x4*)(kb + off); }
    if (needv) {
#pragma unroll
        for (int j = 0; j < 2; ++j) { const unsigned p = (unsigned)tid + 512u * j; const unsigned off = (p >> 3) * (unsigned)vtstride + (p & 7u) * 8u; r[2 + j] = *(const GAS u32x4*)(vb + off); }
    }
}
__device__ __forceinline__ void kv_store(const u32x4 (&r)[4], LAS unsigned char* kl, LAS unsigned char* vl, bool needv, int tid) {
#pragma unroll
    for (int j = 0; j < 2; ++j) { const int p = tid + 512 * j; *(LAS u32x4*)(kl + (p >> 4) * KROW + (p & 15) * 16) = r[j]; }
    if (needv) {
#pragma unroll
        for (int j = 0; j < 2; ++j) { const int p = tid + 512 * j; *(LAS u32x4*)(vl + (p >> 3) * VROW + (p & 7) * 16) = r[2 + j]; }
    }
}
template <int BR, int NT>
__device__ __forceinline__ void branch_step(int i, int n, const LAS int* clist, const bf16_t* __restrict__ kbase0, int kstride, const bf16_t* __restrict__ vbase0, int vtstride,
                                            const bf16x8 (&qf)[NT][4], float (&m)[NT], float (&l)[NT], f32x4 (&O)[NT][8], const int (&t)[NT], int t0w, const LAS float* mylut, const LAS unsigned* mymask,
                                            float inv_l, volatile LAS float* myimp, LAS unsigned char* ck, LAS unsigned char* cv, LAS unsigned char* nk, LAS unsigned char* nv, int tid, int lane) {
    u32x4 r[4];
    const int c = __builtin_amdgcn_readfirstlane(clist[i]);
    if (i + 1 < n) { const int cn = __builtin_amdgcn_readfirstlane(clist[i + 1]); kv_load(r, kbase0 + (size_t)cn * 64 * kstride, kstride, vbase0 + cn * 64, vtstride, BR != 0, tid); }
    bool bit[NT]; bool any = true;
    if (BR == 2) {
        any = false;
#pragma unroll
        for (int nt = 0; nt < NT; ++nt) { const unsigned w = mymask[nt * 64 + (c >> 5)]; bit[nt] = (w >> (c & 31)) & 1u; any = any || bit[nt]; }
    } else {
#pragma unroll
        for (int nt = 0; nt < NT; ++nt) bit[nt] = true;
    }
    if (BR != 2 || __ballot(any) != 0ull) {
        bool far = false;
        if (BR <= 1) far = (t0w - (16 * (c * 64 + 63) + 31)) >= 128;
        else if (BR == 2) far = (t0w - (c * 64 + 63)) >= 128;
        flash_chunk<BR, NT>(far, qf, m, l, O, ck, cv, t, c * 64, mylut, bit, inv_l, myimp, lane);
    }
    if (BR >= 2) {
        if (i + 1 < n) kv_store(r, nk, nv, true, tid);
        __syncthreads();
    } else {
        __syncthreads();
        if (i + 1 < n) kv_store(r, nk, nv, BR != 0, tid);
        __syncthreads();
    }
}
template <int BR, int NT>
__device__ __forceinline__ void run_branch(const LAS int* clist, int n, const bf16_t* __restrict__ kbase0, int kstride, const bf16_t* __restrict__ vbase0, int vtstride,
                                           const bf16x8 (&qf)[NT][4], float (&m)[NT], float (&l)[NT], f32x4 (&O)[NT][8], const int (&t)[NT], const LAS float* mylut, const LAS unsigned* mymask,
                                           float inv_l, volatile LAS float* myimp, LAS unsigned char* kl, LAS unsigned char* vl, LAS unsigned char* kl1, LAS unsigned char* vl1, int tid, int lane) {
    if (n == 0) return;
    asm volatile("" : "+v"(tid), "+v"(lane));
    {
        u32x4 r[4];
        const int c = clist[0];
        kv_load(r, kbase0 + (size_t)c * 64 * kstride, kstride, vbase0 + c * 64, vtstride, BR != 0, tid);
        kv_store(r, kl, vl, BR != 0, tid);
    }
    __syncthreads();
    const int t0w = __builtin_amdgcn_readfirstlane(t[0]);
    if (BR >= 2) {
        for (int i = 0; i < n; i += 2) {
            branch_step<BR, NT>(i, n, clist, kbase0, kstride, vbase0, vtstride, qf, m, l, O, t, t0w, mylut, mymask, inv_l, myimp, kl, vl, kl1, vl1, tid, lane);
            if (i + 1 < n) branch_step<BR, NT>(i + 1, n, clist, kbase0, kstride, vbase0, vtstride, qf, m, l, O, t, t0w, mylut, mymask, inv_l, myimp, kl1, vl1, kl, vl, tid, lane);
        }
    } else {
        for (int i = 0; i < n; ++i)
            branch_step<BR, NT>(i, n, clist, kbase0, kstride, vbase0, vtstride, qf, m, l, O, t, t0w, mylut, mymask, inv_l, myimp, kl, vl, kl, vl, tid, lane);
    }
}

__device__ __forceinline__ void phase_attn(const bf16_t* __restrict__ Q, const float* __restrict__ GATES, const bf16_t* __restrict__ KV, const bf16_t* __restrict__ VTS,
                           const bf16_t* __restrict__ VTW, const bf16_t* __restrict__ KC, const bf16_t* __restrict__ VCT, const float* __restrict__ relb,
                           bf16_t* __restrict__ Oo, LAS unsigned char* lds) {
    LAS float* lut = (LAS float*)lds;
    LAS float* impw = lut + 4 * 132;
    LAS float* comb = impw + 8 * 16 * 132;
    LAS unsigned* selm = (LAS unsigned*)(comb + 8 * 128);
    LAS int* clist = (LAS int*)(selm + 64 * 4);
    LAS unsigned char* kl = (LAS unsigned char*)(clist + 128);
    LAS unsigned char* vl = kl + KTILE_B;
    LAS unsigned char* kl1 = (LAS unsigned char*)impw;
    LAS unsigned char* vl1 = kl1 + KTILE_B;
    for (int idx = blockIdx.x; idx < 512; idx += gridDim.x) {
        const int tid = ltid(), wid = tid >> 6, lane = tid & 63, r = wid & 3, sub = wid >> 2, tok = lane & 15, q = lane >> 4;
        LAS float* myimp = impw + wid * 16 * 132;
        const LAS float* mylut = lut + r * 132;
        const int g = idx & 3, jj = idx >> 2, tt = (jj < 64) ? 127 - jj : jj - 64, h = g * 4 + r;
        __syncthreads();
        for (int e = tid; e < 4 * 129; e += 512) { const int rr = e / 129, n = e % 129; lut[rr * 132 + n] = ((const GAS float*)relb)[t5_bucket_dev(n) * 16 + g * 4 + rr]; }
        for (int half = 0; half < 2; ++half) {
            const int tt32 = tt * 2 + half;
            int t1[1]; t1[0] = tt32 * 32 + sub * 16 + tok;
            const int t = t1[0];
            __syncthreads();
            for (int e = lane; e < 16 * 132; e += 64) myimp[e] = 0.f;
            const int nch = ((2 * tt32) >> 6) + 1;
            if (tid < 128) clist[tid] = tid;
            __syncthreads();
            bf16x8 qf[1][4];
#pragma unroll
            for (int kk = 0; kk < 4; ++kk) qf[0][kk] = *(const GAS bf16x8*)(Q + (size_t)t * 2048 + h * 128 + kk * 32 + q * 8);
            f32x4 O[1][8]; float m[1], l[1];
            m[0] = -1e30f; l[0] = 0.f;
            run_branch<0, 1>(clist, nch, KC + (size_t)(g * 512) * 256, 256, VCT + g * 512, 2048, qf, m, l, O, t1, mylut, nullptr, 0.f, myimp, kl, vl, kl1, vl1, tid, lane);
            const float inv_l = l[0] > 0.f ? 1.f / l[0] : 0.f;
            l[0] = 0.f;
#pragma unroll
            for (int dt = 0; dt < 8; ++dt) O[0][dt] = (f32x4){0.f, 0.f, 0.f, 0.f};
            run_branch<1, 1>(clist, nch, KC + (size_t)(g * 512) * 256, 256, VCT + g * 512, 2048, qf, m, l, O, t1, mylut, nullptr, inv_l, myimp, kl, vl, kl1, vl1, tid, lane);
            { const float g0 = ((const GAS float*)GATES)[(size_t)t * 48 + g * 12 + r * 3 + 0];
#pragma unroll
              for (int dt = 0; dt < 8; ++dt) store_bf4(Oo + (size_t)t * 2048 + h * 128 + dt * 16 + q * 4, O[0][dt] * (inv_l * g0)); }
            __syncthreads();
            {
                LAS float* cb = comb + wid * 128;
                for (int i = 0; i < 4; ++i) {
                    const int tk = wid * 4 + i, sb = tk >> 4, row = tk & 15, tq = tt32 * 32 + tk, cur = tq >> 6;
                    float v0 = 0.f, v1 = 0.f;
#pragma unroll
                    for (int rr = 0; rr < 4; ++rr) { const LAS float* ip = impw + ((sb * 4 + rr) * 16 + row) * 132; v0 += ip[lane]; v1 += ip[lane + 64]; }
                    cb[lane] = v0; cb[lane + 64] = v1;
                    wave_fence();
                    bool sel0, sel1;
                    if (cur + 1 <= 16) { sel0 = lane <= cur; sel1 = false; }
                    else {
                        int cnt0 = 0, cnt1 = 0;
                        for (int s2 = 1; s2 < cur; ++s2) {
                            const float x = ((volatile LAS float*)cb)[s2];
                            cnt0 += ((x > v0) || (x == v0 && s2 < lane)) ? 1 : 0;
                            cnt1 += ((x > v1) || (x == v1 && s2 < lane + 64)) ? 1 : 0;
                        }
                        const int s0 = lane, s1 = lane + 64;
                        sel0 = (s0 == 0) || (s0 == cur) || (s0 < cur && cnt0 < 14);
                        sel1 = (s1 == cur) || (s1 < cur && cnt1 < 14);
                    }
                    const unsigned long long b0 = __ballot(sel0), b1 = __ballot(sel1);
                    const int ts = half * 32 + tk;
                    if (lane == 0) { selm[ts * 4 + 0] = (unsigned)b0; selm[ts * 4 + 1] = (unsigned)(b0 >> 32); selm[ts * 4 + 2] = (unsigned)b1; selm[ts * 4 + 3] = (unsigned)(b1 >> 32); }
                    wave_fence();
                }
            }
        }
        __syncthreads();
        const int smax = tt;
        if (tid == 0) {
            unsigned u0 = 0, u1 = 0, u2 = 0, u3 = 0;
            for (int k = 0; k < 64; ++k) { u0 |= selm[k * 4 + 0]; u1 |= selm[k * 4 + 1]; u2 |= selm[k * 4 + 2]; u3 |= selm[k * 4 + 3]; }
            int n = 0;
            for (int s = 0; s <= smax; ++s) { const unsigned w = s < 32 ? u0 : (s < 64 ? u1 : (s < 96 ? u2 : u3)); if ((w >> (s & 31)) & 1u) clist[n++] = s; }
            clist[127] = n;
        }
        __syncthreads();
        const int nsel = clist[127];
        {
            const int th = sub;
            int t2[2]; t2[0] = tt * 64 + th * 32 + tok; t2[1] = t2[0] + 16;
            bf16x8 qf[2][4];
#pragma unroll
            for (int nt = 0; nt < 2; ++nt)
#pragma unroll
                for (int kk = 0; kk < 4; ++kk) qf[nt][kk] = *(const GAS bf16x8*)(Q + (size_t)t2[nt] * 2048 + h * 128 + kk * 32 + q * 8);
            f32x4 O[2][8]; float m[2], l[2];
            m[0] = -1e30f; m[1] = -1e30f; l[0] = 0.f; l[1] = 0.f;
#pragma unroll
            for (int nt = 0; nt < 2; ++nt)
#pragma unroll
                for (int dt = 0; dt < 8; ++dt) O[nt][dt] = (f32x4){0.f, 0.f, 0.f, 0.f};
            run_branch<2, 2>(clist, nsel, KV + 1024 + g * 128, 3072, VTS + (size_t)(g * 128) * 8192, 8192, qf, m, l, O, t2, mylut, selm + (th * 32 + tok) * 4, 0.f, myimp, kl, vl, kl1, vl1, tid, lane);
#pragma unroll
            for (int nt = 0; nt < 2; ++nt) {
                const float sc = l[nt] > 0.f ? ((const GAS float*)GATES)[(size_t)t2[nt] * 48 + g * 12 + r * 3 + 1] / l[nt] : 0.f;
#pragma unroll
                for (int dt = 0; dt < 8; ++dt) {
                    bf16_t* op = Oo + (size_t)t2[nt] * 2048 + h * 128 + dt * 16 + q * 4;
                    const u32x2 w = *(const GAS u32x2*)op;
                    f32x4 v = O[nt][dt] * sc;
                    v[0] += __uint_as_float(w.x << 16); v[1] += __uint_as_float(w.x & 0xffff0000u); v[2] += __uint_as_float(w.y << 16); v[3] += __uint_as_float(w.y & 0xffff0000u);
                    store_bf4(op, v);
                }
                __builtin_amdgcn_sched_barrier(0);
            }
            const int lo = (tt * 64 - 511 > 0 ? tt * 64 - 511 : 0) >> 6, hi = smax;
            if (tid <= hi - lo) clist[tid] = lo + tid;
            __syncthreads();
            m[0] = -1e30f; m[1] = -1e30f; l[0] = 0.f; l[1] = 0.f;
#pragma unroll
            for (int nt = 0; nt < 2; ++nt)
#pragma unroll
                for (int dt = 0; dt < 8; ++dt) O[nt][dt] = (f32x4){0.f, 0.f, 0.f, 0.f};
            run_branch<3, 2>(clist, hi - lo + 1, KV + 2048 + g * 128, 3072, VTW + (size_t)(g * 128) * 8192, 8192, qf, m, l, O, t2, mylut, nullptr, 0.f, myimp, kl, vl, kl1, vl1, tid, lane);
#pragma unroll
            for (int nt = 0; nt < 2; ++nt) {
                const float sc = l[nt] > 0.f ? ((const GAS float*)GATES)[(size_t)t2[nt] * 48 + g * 12 + r * 3 + 2] / l[nt] : 0.f;
#pragma unroll
                for (int dt = 0; dt < 8; ++dt) {
                    bf16_t* op = Oo + (size_t)t2[nt] * 2048 + h * 128 + dt * 16 + q * 4;
                    const u32x2 w = *(const GAS u32x2*)op;
                    f32x4 v = O[nt][dt] * sc;
                    v[0] += __uint_as_float(w.x << 16); v[1] += __uint_as_float(w.x & 0xffff0000u); v[2] += __uint_as_float(w.y << 16); v[3] += __uint_as_float(w.y & 0xffff0000u);
                    store_bf4(op, v);
                }
                __builtin_amdgcn_sched_barrier(0);
            }
        }
    }
}

enum { K_NC = 0, K_MIX, K_GEMM, K_PREP, K_SCAN, K_POST, K_IM2COL, K_ATTN };
#ifndef REP_KIND
#define REP_KIND (-1)
#endif
constexpr int NPH = 39, MAX_JOBS = 44, MAX_CONV = 40;
struct PhaseDesc { int kind, njobs, jfirst, total, K, lda, ldb, nconv, cfirst, sub, pad0, pad1; const void* ptr[10]; };
static_assert(sizeof(PhaseDesc) == 128 && NPH * 128 <= LDS_JOBS - LDS_DESC, "desc table");
static_assert(sizeof(Job) == 64 && MAX_JOBS * 64 <= LDS_CONV - LDS_JOBS, "job table");
static_assert(sizeof(Conv) == 32 && MAX_CONV * 32 <= LDS_WORK - LDS_CONV, "conv table");
struct Builder {
    LAS PhaseDesc* pd; LAS Job* jobs; LAS Conv* cv; int nph, nj, nc;
    __device__ __forceinline__ LAS PhaseDesc* phase(int kind) {
        __builtin_amdgcn_sched_barrier(0);
        LAS PhaseDesc* d = pd + nph; ++nph;
        d->kind = kind; d->njobs = 0; d->jfirst = nj; d->total = 0; d->K = D; d->lda = D; d->ldb = D; d->nconv = 0; d->cfirst = nc; d->sub = 0; d->pad0 = (kind == K_PREP) ? 0 : 1; d->pad1 = 0;
#pragma unroll
        for (int i = 0; i < 10; ++i) d->ptr[i] = nullptr;
        return d;
    }
    __device__ __forceinline__ void job(LAS PhaseDesc* d, const void* A, const void* Bt, void* out, const void* aux, const void* aux2, int nM, int nN, int ldc, int mode) {
        __builtin_amdgcn_sched_barrier(0);
        LAS Job* j = jobs + nj; ++nj;
        j->A = (const bf16_t*)A; j->Bt = (const bf16_t*)Bt; j->out = out; j->aux = (const float*)aux; j->aux2 = (const float*)aux2;
        j->nM = nM; j->nN = nN; j->ldc = ldc; j->mode = mode; j->ustart = d->total; j->pad0 = 0;
        d->total = d->total + nM * nN; d->njobs = d->njobs + 1; if (mode == EP_RESID || mode == EP_VMIX) d->pad0 = 0;
    }
    __device__ __forceinline__ void conv(LAS PhaseDesc* d, const float* src, int K, int N, void* dst, int Kp, int Np) {
        __builtin_amdgcn_sched_barrier(0);
        LAS Conv* c = cv + nc; ++nc; c->src = src; c->dst = (bf16_t*)dst; c->K = K; c->N = N; c->Kp = Kp; c->Np = Np; d->nconv = d->nconv + 1;
    }
};

__device__ __forceinline__ const float* vlaunder(const float* x) { asm volatile("" : "+v"(x)); return x; }
#define PIN(i) vlaunder(p.in[i])
#define H ((float*)(ws + OFF_H))
#define X6 ((bf16_t*)(ws + OFF_X6))
#define Rb ((float*)(ws + OFF_R))
#define Wb ((float*)(ws + OFF_W))
#define Kb ((float*)(ws + OFF_K))
#define Vb ((float*)(ws + OFF_V))
#define VFb ((float*)(ws + OFF_VF))
#define NAb ((float*)(ws + OFF_NA))
#define AAb ((float*)(ws + OFF_AA))
#define BONb ((float*)(ws + OFF_BON))
#define Yb ((float*)(ws + OFF_Y))
#define Gb ((float*)(ws + OFF_G))
#define TW ((bf16_t*)(ws + OFF_TW))
#define TA ((bf16_t*)(ws + OFF_TA))
#define TV ((bf16_t*)(ws + OFF_TV))
#define TG ((bf16_t*)(ws + OFF_TG))
#define Zb ((bf16_t*)(ws + OFF_Z))
#define UPT ((bf16_t*)(ws + OFF_MLPW))
#define DNT ((bf16_t*)(ws + OFF_MLPW + 32 * MiB))
#define KVN ((bf16_t*)(ws + OFF_KVN))
#define HN ((bf16_t*)(ws + OFF_HN))
#define KV ((bf16_t*)(ws + OFF_KV))
#define VTS ((bf16_t*)(ws + OFF_VTS))
#define VTW ((bf16_t*)(ws + OFF_VTW))
#define Qb ((bf16_t*)(ws + OFF_Q))
#define GATES ((float*)(ws + OFF_GATES))
#define ACMP ((bf16_t*)(ws + OFF_ACMP))
#define HID ((bf16_t*)(ws + OFF_HID))
#define KC ((bf16_t*)(ws + OFF_KC))
#define VCT ((bf16_t*)(ws + OFF_VCT))
#define Ob ((bf16_t*)(ws + OFF_O))
#define WKV ((bf16_t*)(ws + OFF_WKV))
#define C1 ((float*)(ws + OFF_C1))
#define C1P ((float*)(ws + OFF_C1P))
__device__ __forceinline__ void build_program(const Params& p, LAS unsigned char* lds0) {
    Builder b; b.pd = (LAS PhaseDesc*)(lds0 + LDS_DESC); b.jobs = (LAS Job*)(lds0 + LDS_JOBS); b.cv = (LAS Conv*)(lds0 + LDS_CONV); b.nph = 0; b.nj = 0; b.nc = 0;
    unsigned char* ws = p.ws; asm volatile("" : "+v"(ws));
    const size_t XS = (size_t)T * D;
    LAS PhaseDesc* d;
    asm volatile("" : "+v"(ws)); d = b.phase(K_NC); d->sub = 1; d->ptr[0] = H; d->ptr[6] = PIN(0); d->ptr[7] = PIN(25); d->ptr[8] = PIN(26); d->ptr[9] = C1P;
    {
        unsigned char* w2 = ws + OFF_RW;
        b.conv(d, PIN(3), D, D, w2 + RW_WR, D, D);
        b.conv(d, PIN(4), D, D, w2 + RW_WK, D, D);
        b.conv(d, PIN(5), D, D, w2 + RW_WV, D, D);
        b.conv(d, PIN(6), D, D, w2 + RW_WO, D, D);
        b.conv(d, PIN(8), D, 96, w2 + RW_W1, D, 256);
        b.conv(d, PIN(11), D, 128, w2 + RW_A1, D, 256);
        b.conv(d, PIN(16), D, 256, w2 + RW_G1, D, 256);
        b.conv(d, PIN(9), 96, D, w2 + RW_W2, 256, D);
        b.conv(d, PIN(12), 128, D, w2 + RW_A2, 256, D);
        b.conv(d, PIN(17), 256, D, w2 + RW_G2, 256, D);
    }
    auto mlp = [&](int L, bf16_t* XN, bf16_t* U) {
        asm volatile("" : "+v"(ws)); d = b.phase(K_NC); d->ptr[0] = H; d->ptr[1] = PIN(33) + (size_t)L * D; d->ptr[2] = XN;
        bf16_t* up_t = (L == 2) ? (bf16_t*)(ws + OFF_MLPW2) : UPT; bf16_t* dn_t = (L == 2) ? (bf16_t*)(ws + OFF_MLPW2 + 32 * MiB) : DNT;
        if (L == 3) {
            b.conv(d, PIN(34) + (size_t)L * D * DFF, D, DFF, UPT, D, DFF);
            b.conv(d, PIN(35) + (size_t)L * DFF * D, DFF, D, DNT, DFF, D);
        }
        asm volatile("" : "+v"(ws)); d = b.phase(K_GEMM); b.job(d, XN, up_t, U, nullptr, nullptr, 32, 32, DFF, EP_RELU2);
        asm volatile("" : "+v"(ws)); d = b.phase(K_GEMM); d->K = DFF; d->lda = DFF; d->ldb = DFF; b.job(d, U, dn_t, H, nullptr, nullptr, 32, 8, D, EP_RESID);
    };
#pragma unroll
    for (int i = 0; i < 2; ++i) {
        unsigned char* wb = ws + OFF_RW + i * RW_STRIDE;
        float* Vcur = (i == 0) ? VFb : Vb;
        asm volatile("" : "+v"(ws)); d = b.phase(K_MIX); d->ptr[0] = H; d->ptr[1] = PIN(1) + (size_t)i * D; d->ptr[2] = PIN(2) + (size_t)i * 6 * D; d->ptr[3] = X6;
        asm volatile("" : "+v"(ws)); d = b.phase(K_GEMM);
        b.job(d, X6 + 0 * XS, wb + RW_WR, Rb, nullptr, nullptr, 32, 8, D, EP_F32);
        b.job(d, X6 + 2 * XS, wb + RW_WK, Kb, nullptr, nullptr, 32, 8, D, EP_F32);
        b.job(d, X6 + 3 * XS, wb + RW_WV, Vcur, nullptr, nullptr, 32, 8, D, EP_F32);
        b.job(d, X6 + 1 * XS, wb + RW_W1, TW, nullptr, nullptr, 32, 1, 256, EP_TANH);
        b.job(d, X6 + 4 * XS, wb + RW_A1, TA, nullptr, nullptr, 32, 1, 256, EP_BF16);
        b.job(d, X6 + 5 * XS, wb + RW_G1, TG, nullptr, nullptr, 32, 1, 256, EP_SIGM);
        if (i == 1) b.job(d, X6 + 3 * XS, wb + RW_V1, TV, nullptr, nullptr, 32, 1, 256, EP_BF16);
        asm volatile("" : "+v"(ws)); d = b.phase(K_GEMM); d->K = 256; d->lda = 256; d->ldb = 256;
        b.job(d, TW, wb + RW_W2, Wb, PIN(7) + (size_t)i * D, nullptr, 32, 8, D, EP_DECAY);
        b.job(d, TA, wb + RW_A2, AAb, PIN(10) + (size_t)i * D, nullptr, 32, 8, D, EP_SIGB);
        b.job(d, TG, wb + RW_G2, Gb, nullptr, nullptr, 32, 8, D, EP_F32);
        if (i == 1) b.job(d, TV, wb + RW_V2, Vb, PIN(13), VFb, 32, 8, D, EP_VMIX);
        asm volatile("" : "+v"(ws)); d = b.phase(K_PREP); d->ptr[0] = Rb; d->ptr[1] = Kb; d->ptr[2] = AAb; d->ptr[3] = NAb; d->ptr[4] = BONb;
        d->ptr[5] = PIN(18) + (size_t)i * D; d->ptr[6] = PIN(19) + (size_t)i * D; d->ptr[7] = PIN(20) + (size_t)i * D;
        asm volatile("" : "+v"(ws)); d = b.phase(K_SCAN); d->ptr[0] = Rb; d->ptr[1] = Wb; d->ptr[2] = Kb; d->ptr[3] = Vcur; d->ptr[4] = NAb; d->ptr[5] = AAb; d->ptr[6] = Yb;
        b.conv(d, PIN(34) + (size_t)i * D * DFF, D, DFF, UPT, D, DFF);
        b.conv(d, PIN(35) + (size_t)i * DFF * D, DFF, D, DNT, DFF, D);
        if (i == 0) {
            {
                unsigned char* w2 = ws + OFF_RW + RW_STRIDE;
                b.conv(d, PIN(3) + (size_t)D * D, D, D, w2 + RW_WR, D, D);
                b.conv(d, PIN(4) + (size_t)D * D, D, D, w2 + RW_WK, D, D);
                b.conv(d, PIN(5) + (size_t)D * D, D, D, w2 + RW_WV, D, D);
                b.conv(d, PIN(6) + (size_t)D * D, D, D, w2 + RW_WO, D, D);
                b.conv(d, PIN(8) + (size_t)D * 96, D, 96, w2 + RW_W1, D, 256);
                b.conv(d, PIN(11) + (size_t)D * 128, D, 128, w2 + RW_A1, D, 256);
                b.conv(d, PIN(16) + (size_t)D * 256, D, 256, w2 + RW_G1, D, 256);
                b.conv(d, PIN(9) + (size_t)96 * D, 96, D, w2 + RW_W2, 256, D);
                b.conv(d, PIN(12) + (size_t)128 * D, 128, D, w2 + RW_A2, 256, D);
                b.conv(d, PIN(17) + (size_t)256 * D, 256, D, w2 + RW_G2, 256, D);
                b.conv(d, PIN(14), D, 64, w2 + RW_V1, D, 256);
                b.conv(d, PIN(15), 64, D, w2 + RW_V2, 256, D);
            }
            b.conv(d, PIN(24), D, 3072, ws + OFF_WKV, D, 3072);
#pragma unroll
            for (int q = 0; q < 2; ++q) {
                b.conv(d, PIN(26) + (size_t)q * 4096 * 128, 4096, 128, ws + OFF_CW1 + q * 2 * MiB, 4096, 256);
                b.conv(d, PIN(28) + (size_t)q * 128 * 128, 128, 128, ws + OFF_CW2 + q * 131072, 256, 256);
                b.conv(d, PIN(30) + (size_t)q * D * 2096, D, 2096, ws + OFF_WQ + q * WQ_STRIDE, D, 2304);
                b.conv(d, PIN(31) + (size_t)q * D * D, D, D, ws + OFF_NWO + q * 8 * MiB, D, D);
            }
        } else {
            b.conv(d, PIN(34) + (size_t)2 * D * DFF, D, DFF, ws + OFF_MLPW2, D, DFF);
            b.conv(d, PIN(35) + (size_t)2 * DFF * D, DFF, D, ws + OFF_MLPW2 + 32 * MiB, DFF, D);
        }
        asm volatile("" : "+v"(ws)); d = b.phase(K_POST); d->ptr[0] = Yb; d->ptr[1] = BONb; d->ptr[2] = Vcur; d->ptr[3] = Gb; d->ptr[4] = PIN(21) + (size_t)i * D; d->ptr[5] = PIN(22) + (size_t)i * D; d->ptr[6] = Zb;
        asm volatile("" : "+v"(ws)); d = b.phase(K_GEMM); b.job(d, Zb, wb + RW_WO, H, nullptr, nullptr, 32, 8, D, EP_RESID);
        mlp(i, (bf16_t*)(ws + OFF_XN), (bf16_t*)(ws + OFF_U));
    }
#pragma unroll
    for (int j = 0; j < 2; ++j) {
        asm volatile("" : "+v"(ws)); d = b.phase(K_NC); d->ptr[0] = H;
        if (j == 0) { d->ptr[1] = PIN(23); d->ptr[2] = KVN; d->ptr[3] = PIN(29); d->ptr[4] = HN; }
        else { d->ptr[1] = PIN(29) + D; d->ptr[2] = HN; }
        asm volatile("" : "+v"(ws)); d = b.phase(K_GEMM);
        if (j == 0) {
            b.job(d, KVN, WKV, KV, nullptr, nullptr, 32, 6, 3072, EP_BF16);
            b.job(d, KVN, WKV + (size_t)2048 * D, KV + 2048, nullptr, nullptr, 32, 2, 3072, EP_BF16);
            b.job(d, WKV + (size_t)1536 * D, KVN, VTS, nullptr, nullptr, 2, 32, T, EP_BF16);
            b.job(d, WKV + (size_t)2560 * D, KVN, VTW, nullptr, nullptr, 2, 32, T, EP_BF16);
        }
        b.job(d, HN, ws + OFF_WQ + (size_t)j * WQ_STRIDE, Qb, GATES, nullptr, 32, 9, 2048, EP_Q);
        if (j == 0) {
            asm volatile("" : "+v"(ws)); d = b.phase(K_IM2COL); d->ptr[0] = KV; d->ptr[1] = ACMP; d->ptr[2] = C1P; d->ptr[3] = PIN(27); d->ptr[4] = C1;
            asm volatile("" : "+v"(ws)); d = b.phase(K_GEMM); d->K = 4096; d->lda = 4096; d->ldb = 4096;
            b.job(d, ACMP, ws + OFF_CW1, HID, C1, nullptr, 8, 1, 256, EP_GELU);
            b.job(d, ACMP + (size_t)2048 * 4096, ws + OFF_CW1 + 2 * MiB, HID + (size_t)2048 * 256, C1 + 256, nullptr, 8, 1, 256, EP_GELU);
            asm volatile("" : "+v"(ws)); d = b.phase(K_GEMM); d->K = 256; d->lda = 256; d->ldb = 256;
            b.job(d, HID, ws + OFF_CW2, KC, nullptr, nullptr, 8, 1, 256, EP_BF16);
            b.job(d, ws + OFF_CW2 + 131072, HID + (size_t)2048 * 256, VCT, nullptr, nullptr, 1, 8, 2048, EP_BF16);
        }
        asm volatile("" : "+v"(ws)); d = b.phase(K_ATTN); d->ptr[0] = Qb; d->ptr[1] = GATES; d->ptr[2] = KV; d->ptr[3] = VTS; d->ptr[4] = VTW; d->ptr[5] = KC; d->ptr[6] = VCT; d->ptr[7] = PIN(32); d->ptr[8] = Ob;
        asm volatile("" : "+v"(ws)); d = b.phase(K_GEMM); b.job(d, Ob, ws + OFF_NWO + (size_t)j * 8 * MiB, H, nullptr, nullptr, 32, 8, D, EP_RESID);
        mlp(2 + j, (bf16_t*)(ws + OFF_XN2), (bf16_t*)(ws + OFF_U2));
    }
    asm volatile("" : "+v"(ws)); d = b.phase(K_NC); d->ptr[0] = H; d->ptr[1] = PIN(36); { float* po = p.out; asm volatile("" : "+v"(po)); d->ptr[5] = po; }
}

#undef H
#undef X6
#undef Rb
#undef Wb
#undef Kb
#undef Vb
#undef VFb
#undef NAb
#undef AAb
#undef BONb
#undef Yb
#undef Gb
#undef TW
#undef TA
#undef TV
#undef TG
#undef Zb
#undef UPT
#undef DNT
#undef KVN
#undef HN
#undef KV
#undef VTS
#undef VTW
#undef Qb
#undef GATES
#undef ACMP
#undef HID
#undef KC
#undef VCT
#undef Ob
#undef WKV
#undef C1
#undef C1P
#undef PIN
#define XB_TMO      128
#define XB_XCNT(j)  (256  + 64 * (j))
#define XB_XSUB(j)  (1280 + 64 * (j))
#define XB_XGEN(j)  (2304 + 64 * (j))
#define XB_TOP      3328
#define XB_TOPGEN   3392
#define XCD_BAR_WORDS 3456
#define XB_SPIN_CAP (1u << 18)
constexpr size_t OFF_BAR = OFF_C1 + 16384;
__device__ __forceinline__ unsigned xb_ld(unsigned* p)              { return __hip_atomic_load(p, __ATOMIC_RELAXED, __HIP_MEMORY_SCOPE_AGENT); }
__device__ __forceinline__ unsigned xb_add(unsigned* p, unsigned v) { return __hip_atomic_fetch_add(p, v, __ATOMIC_RELAXED, __HIP_MEMORY_SCOPE_AGENT); }
__device__ __forceinline__ unsigned xb_xcc_id() { return (unsigned)__builtin_amdgcn_s_getreg((3 << 11) | 20) & 0xFu; }
#define XB_SPIN(cond, bar) do { unsigned _sp = 0; while (cond) { __builtin_amdgcn_s_sleep(1); \
    if ((++_sp & 255u) == 0u) { if (xb_ld(&(bar)[XB_TMO])) break; if (_sp > XB_SPIN_CAP) { atomicAdd(&(bar)[XB_TMO], 1u); break; } } } } while (0)
__device__ __forceinline__ void xcd_barrier_complete(unsigned* bar, unsigned x, unsigned& nloc, unsigned& nx) {
    const unsigned G = gridDim.x * gridDim.y * gridDim.z;
    unsigned sum, cnt, mine, sp = 0u;
    for (;;) {
        sum = 0u; cnt = 0u; mine = 0u;
#pragma unroll
        for (unsigned j = 0; j < 16; ++j) { const unsigned c = xb_ld(&bar[XB_XCNT(j)]); sum += c; cnt += (c > 0u) ? 1u : 0u; mine = (j == x) ? c : mine; }
        if (sum == G) break;
        __builtin_amdgcn_s_sleep(1);
        if ((++sp & 255u) == 0u) { if (xb_ld(&bar[XB_TMO])) break; if (sp > XB_SPIN_CAP) { atomicAdd(&bar[XB_TMO], 1u); break; } }
    }
    nloc = mine > 0u ? mine : 1u; nx = cnt > 0u ? cnt : 1u;
}
__device__ __forceinline__ void xcd_barrier(unsigned* bar, volatile LAS unsigned* st) {
    asm volatile("s_waitcnt vmcnt(0)" ::: "memory");
    __syncthreads();
    if (threadIdx.x == 0) {
        const unsigned x = xb_xcc_id();
        __builtin_amdgcn_s_waitcnt(0);
        unsigned nloc = st[0], nx = st[1];
        if (nloc == 0u) { xcd_barrier_complete(bar, x, nloc, nx); st[0] = nloc; st[1] = nx; }
        const unsigned old = xb_add(&bar[XB_XSUB(x)], 1u);
        const unsigned gen = old / nloc;
        if (old + 1u == (gen + 1u) * nloc) {
            __builtin_amdgcn_fence(__ATOMIC_RELEASE, "agent");
            asm volatile("s_waitcnt vmcnt(0)" ::: "memory");
            const unsigned og = xb_add(&bar[XB_TOP], 1u);
            const unsigned tg = og / nx;
            if (og + 1u == (tg + 1u) * nx) xb_add(&bar[XB_TOPGEN], 1u);
            else XB_SPIN(xb_ld(&bar[XB_TOPGEN]) == tg, bar);
            __builtin_amdgcn_fence(__ATOMIC_ACQUIRE, "agent");
            xb_add(&bar[XB_XGEN(x)], 1u);
            asm volatile("s_waitcnt vmcnt(0)" ::: "memory");
        } else {
            XB_SPIN(xb_ld(&bar[XB_XGEN(x)]) == gen, bar);
            __builtin_amdgcn_fence(__ATOMIC_ACQUIRE, "agent");
            asm volatile("s_waitcnt vmcnt(0)" ::: "memory");
        }
    }
    __syncthreads();
}

__global__ void __launch_bounds__(512, 2) mega(Params p) {
    extern __shared__ __attribute__((aligned(16))) unsigned char smem[];
    LAS unsigned char* lds0 = (LAS unsigned char*)smem;
    cg::grid_group grid = cg::this_grid();
    volatile LAS unsigned* bar_st = (volatile LAS unsigned*)(lds0 + LDS_DESC + NPH * 128 + 96);
    if (threadIdx.x == 0) {
        bar_st[0] = 0u; bar_st[1] = 0u;
        (void)xb_add(&((unsigned*)(p.ws + OFF_BAR))[XB_XCNT(xb_xcc_id())], 1u);
        build_program(p, lds0);
        LAS unsigned char* ord = lds0 + LDS_DESC + NPH * 128; int n = 0;
        for (int i = 0; i < NPH; ++i) {
            const LAS PhaseDesc* dd = (const LAS PhaseDesc*)(lds0 + LDS_DESC) + i;
            ord[n++] = (unsigned char)i;
            if (dd->kind == REP_KIND && dd->pad0) ord[n++] = (unsigned char)i;
        }
        ord[127] = (unsigned char)n;
    }
    __syncthreads();
    const int nord = __builtin_amdgcn_readfirstlane((int)lds0[LDS_DESC + NPH * 128 + 127]);
    for (int oi = 0; oi < nord; ++oi) {
        const int ph = __builtin_amdgcn_readfirstlane((int)lds0[LDS_DESC + NPH * 128 + oi]);
        const int tid = ltid(), nb = gridDim.x, bid = blockIdx.x;
        LAS unsigned char* lds = lds0 + LDS_WORK;
        const LAS PhaseDesc* d = (const LAS PhaseDesc*)(lds0 + LDS_DESC) + ph;
        const int kind = __builtin_amdgcn_readfirstlane(d->kind);
        if (kind == K_NC) {
            const float* Hh = uptr((const float*)d->ptr[0]);
            if (d->sub == 1) {
                const f32x4* xs = (const f32x4*)d->ptr[6];
                for (size_t i = (size_t)bid * 512 + tid; i < (size_t)T * D / 4; i += (size_t)nb * 512) ((f32x4*)Hh)[i] = xs[i];
                if (bid < 16) {
                    const int q = bid >> 3, ks = (bid & 7) * 4 + (tid >> 7), n = tid & 127;
                    const float* pe = (const float*)d->ptr[7] + (size_t)q * 4096; const float* w1 = (const float*)d->ptr[8] + (size_t)q * 4096 * 128;
                    float s = 0.f;
                    for (int k = ks * 128; k < ks * 128 + 128; ++k) s += pe[k] * w1[(size_t)k * 128 + n];
                    ((float*)d->ptr[9])[(q * 32 + ks) * 128 + n] = s;
                }
            }
            const float* g1 = uptr((const float*)d->ptr[1]);
            if (g1) phase_norm(Hh, g1, uptr((bf16_t*)d->ptr[2]), uptr((const float*)d->ptr[3]), uptr((bf16_t*)d->ptr[4]), uptr((float*)d->ptr[5]));
            __syncthreads();
            int off = 0;
            const int nconv = __builtin_amdgcn_readfirstlane(d->nconv), cfirst = __builtin_amdgcn_readfirstlane(d->cfirst);
            for (int c = 0; c < nconv; ++c) {
                const LAS Conv* cc = (const LAS Conv*)(lds0 + LDS_CONV) + cfirst + c;
                convT(uptr(cc->src), __builtin_amdgcn_readfirstlane(cc->K), __builtin_amdgcn_readfirstlane(cc->N), uptr(cc->dst), __builtin_amdgcn_readfirstlane(cc->Kp),
                      __builtin_amdgcn_readfirstlane(cc->Np), (LAS float*)lds, off);
            }
        } else if (kind == K_MIX) {
            phase_mix(uptr((const float*)d->ptr[0]), uptr((const float*)d->ptr[1]), uptr((const float*)d->ptr[2]), uptr((bf16_t*)d->ptr[3]));
        } else if (kind == K_GEMM) {
            gemm_phase(lds, (const LAS Job*)(lds0 + LDS_JOBS) + __builtin_amdgcn_readfirstlane(d->jfirst), __builtin_amdgcn_readfirstlane(d->njobs), __builtin_amdgcn_readfirstlane(d->total),
                       __builtin_amdgcn_readfirstlane(d->K), __builtin_amdgcn_readfirstlane(d->lda), __builtin_amdgcn_readfirstlane(d->ldb));
        } else if (kind == K_PREP) {
            phase_prep(uptr((const float*)d->ptr[0]), uptr((float*)d->ptr[1]), uptr((float*)d->ptr[2]), uptr((float*)d->ptr[3]), uptr((float*)d->ptr[4]),
                       uptr((const float*)d->ptr[5]), uptr((const float*)d->ptr[6]), uptr((const float*)d->ptr[7]));
        } else if (kind == K_SCAN) {
            phase_scan(uptr((const float*)d->ptr[0]), uptr((const float*)d->ptr[1]), uptr((const float*)d->ptr[2]), uptr((const float*)d->ptr[3]), uptr((const float*)d->ptr[4]),
                       uptr((const float*)d->ptr[5]), uptr((float*)d->ptr[6]), lds, (const LAS Conv*)(lds0 + LDS_CONV) + __builtin_amdgcn_readfirstlane(d->cfirst), __builtin_amdgcn_readfirstlane(d->nconv));
        } else if (kind == K_POST) {
            phase_post(uptr((const float*)d->ptr[0]), uptr((const float*)d->ptr[1]), uptr((const float*)d->ptr[2]), uptr((const float*)d->ptr[3]), uptr((const float*)d->ptr[4]),
                       uptr((const float*)d->ptr[5]), uptr((bf16_t*)d->ptr[6]));
        } else if (kind == K_IM2COL) {
            const bf16_t* KV = uptr((const bf16_t*)d->ptr[0]); bf16_t* ACMP = uptr((bf16_t*)d->ptr[1]);
            for (size_t i = (size_t)bid * 512 + tid; i < (size_t)2 * 2048 * 512; i += (size_t)nb * 512) {
                const int k8 = (int)(i & 511), row = (int)((i >> 9) & 2047), q = (int)(i >> 20);
                const int c = row & 511, g = row >> 9, k = k8 * 8, l = k >> 7, dd = k & 127;
                u32x4 v = {0u, 0u, 0u, 0u};
                if (c < 511) v = *(const u32x4*)(KV + (size_t)(16 * c + l) * 3072 + q * 512 + g * 128 + dd);
                *(u32x4*)(ACMP + ((size_t)q * 2048 + row) * 4096 + k) = v;
            }
            if (bid == 0) {
                const int q = tid >> 8, n = tid & 255;
                float s = 0.f;
                if (n < 128) { s = ((const float*)d->ptr[3])[q * 128 + n]; for (int ks = 0; ks < 32; ++ks) s += ((const float*)d->ptr[2])[(q * 32 + ks) * 128 + n]; }
                ((float*)d->ptr[4])[q * 256 + n] = s;
            }
        } else {
            phase_attn(uptr((const bf16_t*)d->ptr[0]), uptr((const float*)d->ptr[1]), uptr((const bf16_t*)d->ptr[2]), uptr((const bf16_t*)d->ptr[3]), uptr((const bf16_t*)d->ptr[4]),
                       uptr((const bf16_t*)d->ptr[5]), uptr((const bf16_t*)d->ptr[6]), uptr((const float*)d->ptr[7]), uptr((bf16_t*)d->ptr[8]), lds);
        }
        if (oi == 0) grid.sync();
        else xcd_barrier((unsigned*)(p.ws + OFF_BAR), bar_st);
    }
}

extern "C" void kernel_launch(void* const* d_in, const int* in_sizes, int n_in, void* d_out, int out_size, void* d_ws, size_t ws_size, hipStream_t stream) {
    static int grid_blocks = 0;
    if (grid_blocks == 0) {
        if (n_in != 37 || ws_size < WS_NEED) { fprintf(stderr, "kernel_launch: unexpected n_in %d or ws_size %zu (need %zu)\n", n_in, ws_size, (size_t)WS_NEED); grid_blocks = -1; return; }
        int dev = 0, cus = 0, per_cu = 0;
        (void)hipGetDevice(&dev);
        (void)hipDeviceGetAttribute(&cus, hipDeviceAttributeMultiprocessorCount, dev);
        (void)hipFuncSetAttribute((const void*)mega, hipFuncAttributeMaxDynamicSharedMemorySize, LDS_BYTES);
        (void)hipOccupancyMaxActiveBlocksPerMultiprocessor(&per_cu, (const void*)mega, 512, LDS_BYTES);
        if (per_cu < 1) { fprintf(stderr, "kernel_launch: occupancy query returned %d\n", per_cu); per_cu = 1; }
        grid_blocks = cus * per_cu;
    }
    if (grid_blocks < 0) return;
    Params p{};
    for (int i = 0; i < 37; ++i) p.in[i] = (const float*)d_in[i];
    p.out = (float*)d_out; p.ws = (unsigned char*)d_ws;
    (void)hipMemsetAsync((unsigned char*)d_ws + OFF_BAR, 0, XCD_BAR_WORDS * sizeof(unsigned), stream);
    void* args[] = {&p};
    hipError_t e = hipLaunchCooperativeKernel((const void*)mega, dim3(grid_blocks), dim3(512), args, LDS_BYTES, stream);
    if (e != hipSuccess) fprintf(stderr, "cooperative launch failed: %s (grid %d)\n", hipGetErrorString(e), grid_blocks);
}
```

```cpp
#include <hip/hip_runtime.h>
#include <hip/hip_cooperative_groups.h>
#include <cstdio>
namespace cg = cooperative_groups;

#define LAS __attribute__((address_space(3)))
#define GAS __attribute__((address_space(1)))
typedef unsigned short bf16_t;
typedef short bf16x8 __attribute__((ext_vector_type(8)));
typedef short bf16x4 __attribute__((ext_vector_type(4)));
typedef float f32x4 __attribute__((ext_vector_type(4)));
typedef float f32x2v __attribute__((ext_vector_type(2)));
typedef unsigned u32x2 __attribute__((ext_vector_type(2)));
typedef unsigned u32x4 __attribute__((ext_vector_type(4)));

constexpr int T = 8192, D = 2048, DFF = 8192;
constexpr size_t MiB = 1ull << 20;
constexpr size_t OFF_RW = 0, RW_STRIDE = 40 * MiB;
constexpr size_t RW_WR = 0, RW_WK = 8 * MiB, RW_WV = 16 * MiB, RW_WO = 24 * MiB, RW_W1 = 32 * MiB, RW_A1 = 33 * MiB, RW_V1 = 34 * MiB, RW_G1 = 35 * MiB,
                 RW_W2 = 36 * MiB, RW_A2 = 37 * MiB, RW_V2 = 38 * MiB, RW_G2 = 39 * MiB;
constexpr size_t OFF_WKV = 80 * MiB, OFF_CW1 = 92 * MiB, OFF_CW2 = 96 * MiB, OFF_WQ = 97 * MiB, WQ_STRIDE = 9 * MiB, OFF_NWO = 115 * MiB,
                 OFF_C1 = 131 * MiB, OFF_C1P = 131 * MiB + 65536, OFF_MLPW = 132 * MiB, OFF_H = 196 * MiB, OFF_S = 260 * MiB;
constexpr size_t OFF_X6 = OFF_S, OFF_R = OFF_S + 192 * MiB, OFF_W = OFF_R + 64 * MiB, OFF_K = OFF_W + 64 * MiB, OFF_V = OFF_K + 64 * MiB, OFF_VF = OFF_V + 64 * MiB,
                 OFF_NA = OFF_VF + 64 * MiB, OFF_AA = OFF_NA + 64 * MiB, OFF_TW = OFF_AA + 64 * MiB, OFF_TA = OFF_TW + 4 * MiB, OFF_TV = OFF_TA + 4 * MiB, OFF_TG = OFF_TV + 4 * MiB,
                 OFF_BON = OFF_TG + 4 * MiB, OFF_RW_END = OFF_BON + 1 * MiB;
constexpr size_t OFF_U = OFF_R, OFF_Y = OFF_X6 + 64 * MiB, OFF_G = OFF_X6 + 128 * MiB, OFF_Z = OFF_X6 + 32 * MiB, OFF_XN = OFF_X6;
constexpr size_t OFF_KVN = OFF_S, OFF_HN = OFF_S + 32 * MiB, OFF_KV = OFF_S + 64 * MiB, OFF_VTS = OFF_S + 112 * MiB, OFF_VTW = OFF_S + 120 * MiB, OFF_Q = OFF_S + 128 * MiB,
                 OFF_GATES = OFF_S + 160 * MiB, OFF_ACMP = OFF_S + 162 * MiB, OFF_HID = OFF_S + 194 * MiB, OFF_KC = OFF_S + 196 * MiB, OFF_VCT = OFF_S + 197 * MiB,
                 OFF_O = OFF_S + 198 * MiB, OFF_XN2 = OFF_S + 230 * MiB, OFF_U2 = OFF_S + 262 * MiB;
constexpr size_t OFF_MLPW2 = OFF_RW_END, WS_NEED = OFF_MLPW2 + 64 * MiB;
constexpr int LDS_BYTES = 138 * 1024, LDS_DESC = 0, LDS_JOBS = 5120, LDS_CONV = 7936, LDS_WORK = 9216;

struct Params { const float* in[37]; float* out; unsigned char* ws; };

__device__ __forceinline__ int ltid() { int t = threadIdx.x; asm volatile("" : "+v"(t)); return t; }
__device__ __forceinline__ unsigned cvt_pk_bf16(float lo, float hi) { unsigned r; asm volatile("v_cvt_pk_bf16_f32 %0, %1, %2" : "=v"(r) : "v"(lo), "v"(hi)); return r; }
__device__ __forceinline__ void store_bf4(bf16_t* p, f32x4 v) { u32x2 w; w.x = cvt_pk_bf16(v[0], v[1]); w.y = cvt_pk_bf16(v[2], v[3]); *(u32x2*)p = w; }
__device__ __forceinline__ float wave_sum(float v) {
#pragma unroll
    for (int o = 32; o; o >>= 1) v += __shfl_xor(v, o);
    return v;
}
template <int CTRL> __device__ __forceinline__ float dpp_f(float x) { return __int_as_float(__builtin_amdgcn_update_dpp(0, __float_as_int(x), CTRL, 0xF, 0xF, true)); }
__device__ __forceinline__ float red16(float x) { x += dpp_f<0xB1>(x); x += dpp_f<0x4E>(x); x += dpp_f<0x141>(x); x += dpp_f<0x140>(x); return x; }
__device__ __forceinline__ float xmax4(float x) {
    auto a = __builtin_amdgcn_permlane16_swap(__float_as_uint(x), __float_as_uint(x), false, false);
    x = fmaxf(__uint_as_float(a[0]), __uint_as_float(a[1]));
    auto b = __builtin_amdgcn_permlane32_swap(__float_as_uint(x), __float_as_uint(x), false, false);
    return fmaxf(__uint_as_float(b[0]), __uint_as_float(b[1]));
}
__device__ __forceinline__ float xsum4(float x) {
    auto a = __builtin_amdgcn_permlane16_swap(__float_as_uint(x), __float_as_uint(x), false, false);
    x = __uint_as_float(a[0]) + __uint_as_float(a[1]);
    auto b = __builtin_amdgcn_permlane32_swap(__float_as_uint(x), __float_as_uint(x), false, false);
    return __uint_as_float(b[0]) + __uint_as_float(b[1]);
}
__device__ __forceinline__ float sigmoidf_(float x) { return 1.f / (1.f + __expf(-x)); }
__device__ __forceinline__ float tanhf_(float x) { float e = __expf(2.f * x); return 1.f - 2.f / (e + 1.f); }
__device__ __forceinline__ void wave_fence() { __builtin_amdgcn_fence(__ATOMIC_SEQ_CST, "wavefront"); __builtin_amdgcn_wave_barrier(); }

template <class P> __device__ __forceinline__ P uptr(P x) {
    unsigned long long v = (unsigned long long)x;
    const unsigned lo = __builtin_amdgcn_readfirstlane((unsigned)v), hi = __builtin_amdgcn_readfirstlane((unsigned)(v >> 32));
    return (P)(((unsigned long long)hi << 32) | lo);
}

__device__ __forceinline__ void convT(const float* __restrict__ src, int K, int N, bf16_t* __restrict__ dst, int Kp, int Np, LAS float* tile, int& off) {
    const int tid = ltid(), nb = gridDim.x;
    const int tn = Np / 64, ntile = (Kp / 64) * tn;
    int start = ((int)blockIdx.x - (off % nb) + nb) % nb;
    off += ntile;
    const int kl0 = tid >> 4, nl0 = (tid & 15) * 4;
    f32x4 pv[2];
#define CONV_LOAD(ti_) do { const int k0_ = ((ti_) / tn) * 64, n0_ = ((ti_) % tn) * 64; _Pragma("unroll") for (int i = 0; i < 2; ++i) { \
        const int kk_ = k0_ + kl0 + 32 * i, nn_ = n0_ + nl0; pv[i] = (f32x4){0.f, 0.f, 0.f, 0.f}; \
        if (kk_ < K && nn_ < N) pv[i] = *(const GAS f32x4*)(src + (size_t)kk_ * N + nn_); } } while (0)
    if (start < ntile) CONV_LOAD(start);
    for (int ti = start; ti < ntile; ti += nb) {
        const int k0 = (ti / tn) * 64, n0 = (ti % tn) * 64;
        const f32x4 c0 = pv[0], c1 = pv[1];
        if (ti + nb < ntile) CONV_LOAD(ti + nb);
        tile[(nl0 + 0) * 65 + kl0] = c0[0]; tile[(nl0 + 1) * 65 + kl0] = c0[1]; tile[(nl0 + 2) * 65 + kl0] = c0[2]; tile[(nl0 + 3) * 65 + kl0] = c0[3];
        tile[(nl0 + 0) * 65 + kl0 + 32] = c1[0]; tile[(nl0 + 1) * 65 + kl0 + 32] = c1[1]; tile[(nl0 + 2) * 65 + kl0 + 32] = c1[2]; tile[(nl0 + 3) * 65 + kl0 + 32] = c1[3];
        __syncthreads();
        {
            const int nl = tid >> 3, k8 = (tid & 7) * 8;
            const LAS float* tp = tile + nl * 65 + k8;
            u32x4 w; w.x = cvt_pk_bf16(tp[0], tp[1]); w.y = cvt_pk_bf16(tp[2], tp[3]); w.z = cvt_pk_bf16(tp[4], tp[5]); w.w = cvt_pk_bf16(tp[6], tp[7]);
            *(GAS u32x4*)(dst + (size_t)(n0 + nl) * Kp + k0 + k8) = w;
        }
        __syncthreads();
    }
#undef CONV_LOAD
}

__device__ __forceinline__ void phase_mix(const float* __restrict__ H, const float* __restrict__ gn, const float* __restrict__ mu, bf16_t* __restrict__ X6) {
    const int wid = ltid() >> 6, lane = ltid() & 63;
    for (int row = blockIdx.x * 8 + wid; row < T; row += gridDim.x * 8) {
        const float* hp = H + (size_t)row * D;
        f32x4 x[8], xp[8];
        float ss = 0.f, ssp = 0.f;
#pragma unroll
        for (int i = 0; i < 8; ++i) { x[i] = *(const f32x4*)(hp + i * 256 + lane * 4); ss += x[i][0] * x[i][0] + x[i][1] * x[i][1] + x[i][2] * x[i][2] + x[i][3] * x[i][3]; }
        if (row > 0) {
#pragma unroll
            for (int i = 0; i < 8; ++i) { xp[i] = *(const f32x4*)(hp - D + i * 256 + lane * 4); ssp += xp[i][0] * xp[i][0] + xp[i][1] * xp[i][1] + xp[i][2] * xp[i][2] + xp[i][3] * xp[i][3]; }
        } else {
#pragma unroll
            for (int i = 0; i < 8; ++i) xp[i] = (f32x4){0.f, 0.f, 0.f, 0.f};
        }
        ss = wave_sum(ss); ssp = wave_sum(ssp);
        const float rs = rsqrtf(ss * (1.f / D) + 1e-6f), rsp = row > 0 ? rsqrtf(ssp * (1.f / D) + 1e-6f) : 0.f;
#pragma unroll
        for (int i = 0; i < 8; ++i) {
            const int col = i * 256 + lane * 4;
            const f32x4 g4 = *(const f32x4*)(gn + col);
            const f32x4 xn = x[i] * rs * g4, dx = xp[i] * rsp * g4 - xn;
#pragma unroll
            for (int j = 0; j < 6; ++j) {
                const f32x4 m4 = *(const f32x4*)(mu + j * D + col);
                store_bf4(X6 + (size_t)j * T * D + (size_t)row * D + col, xn + dx * m4);
            }
        }
    }
}
__device__ __forceinline__ void phase_norm(const float* __restrict__ H, const float* __restrict__ g1, bf16_t* __restrict__ o1, const float* __restrict__ g2, bf16_t* __restrict__ o2, float* __restrict__ fout) {
    const int wid = ltid() >> 6, lane = ltid() & 63;
    for (int row = blockIdx.x * 8 + wid; row < T; row += gridDim.x * 8) {
        const float* hp = H + (size_t)row * D;
        f32x4 x[8]; float ss = 0.f;
#pragma unroll
        for (int i = 0; i < 8; ++i) { x[i] = *(const f32x4*)(hp + i * 256 + lane * 4); ss += x[i][0] * x[i][0] + x[i][1] * x[i][1] + x[i][2] * x[i][2] + x[i][3] * x[i][3]; }
        ss = wave_sum(ss);
        const float rs = rsqrtf(ss * (1.f / D) + 1e-6f);
#pragma unroll
        for (int i = 0; i < 8; ++i) {
            const int col = i * 256 + lane * 4;
            const f32x4 y = x[i] * rs * *(const f32x4*)(g1 + col);
            if (fout) *(f32x4*)(fout + (size_t)row * D + col) = y;
            else store_bf4(o1 + (size_t)row * D + col, y);
            if (g2) store_bf4(o2 + (size_t)row * D + col, x[i] * rs * *(const f32x4*)(g2 + col));
        }
    }
}
__device__ __forceinline__ void phase_prep(const float* __restrict__ R, float* __restrict__ Kb, float* __restrict__ AA, float* __restrict__ NA, float* __restrict__ BON,
                           const float* __restrict__ k_k, const float* __restrict__ k_a, const float* __restrict__ r_k) {
    const int wid = ltid() >> 6, lane = ltid() & 63;
    for (int row = blockIdx.x * 8 + wid; row < T; row += gridDim.x * 8) {
#pragma unroll 2
        for (int i = 0; i < 8; ++i) {
            const int col = i * 256 + lane * 4; const size_t o = (size_t)row * D + col;
            const f32x4 k = *(const f32x4*)(Kb + o), a = *(const f32x4*)(AA + o), r = *(const f32x4*)(R + o);
            f32x4 kk = k * *(const f32x4*)(k_k + col);
            float ss = red16(kk[0] * kk[0] + kk[1] * kk[1] + kk[2] * kk[2] + kk[3] * kk[3]);
            kk = kk * rsqrtf(fmaxf(ss, 1e-24f));
            const f32x4 kp = k * (1.f + (a - 1.f) * *(const f32x4*)(k_a + col));
            const f32x4 rk = r * kp * *(const f32x4*)(r_k + col);
            const float bon = red16(rk[0] + rk[1] + rk[2] + rk[3]);
            *(f32x4*)(Kb + o) = kp; *(f32x4*)(NA + o) = -kk; *(f32x4*)(AA + o) = kk * a;
            if ((lane & 15) == 0) BON[(size_t)row * 32 + i * 4 + (lane >> 4)] = bon;
        }
    }
}
__device__ __forceinline__ void phase_post(const float* __restrict__ Y, const float* __restrict__ BON, const float* __restrict__ V, const float* __restrict__ G,
                           const float* __restrict__ lw, const float* __restrict__ lb, bf16_t* __restrict__ Z) {
    const int wid = ltid() >> 6, lane = ltid() & 63;
    for (int row = blockIdx.x * 8 + wid; row < T; row += gridDim.x * 8) {
#pragma unroll 2
        for (int i = 0; i < 8; ++i) {
            const int col = i * 256 + lane * 4; const size_t o = (size_t)row * D + col;
            const f32x4 y = *(const f32x4*)(Y + o);
            const float mean = red16(y[0] + y[1] + y[2] + y[3]) * (1.f / 64.f);
            const f32x4 d = y - mean;
            const float var = red16(d[0] * d[0] + d[1] * d[1] + d[2] * d[2] + d[3] * d[3]) * (1.f / 64.f);
            const f32x4 yn = d * rsqrtf(var + 64e-5f) * *(const f32x4*)(lw + col) + *(const f32x4*)(lb + col);
            const float bon = BON[(size_t)row * 32 + i * 4 + (lane >> 4)];
            store_bf4(Z + o, (yn + bon * *(const f32x4*)(V + o)) * *(const f32x4*)(G + o));
        }
    }
}

struct Conv { const float* src; bf16_t* dst; int K, N, Kp, Np; };
__device__ __forceinline__ void conv_worker(const LAS Conv* cv, int nconv, int wg, int nw, LAS unsigned short* tl, int lane) {
    const int l15 = lane & 15, q = lane >> 4;
    int off = 0;
    for (int ci = 0; ci < nconv; ++ci) {
        const float* __restrict__ src = uptr(cv[ci].src); bf16_t* __restrict__ dst = uptr(cv[ci].dst);
        const int K = __builtin_amdgcn_readfirstlane(cv[ci].K), N = __builtin_amdgcn_readfirstlane(cv[ci].N), Kp = __builtin_amdgcn_readfirstlane(cv[ci].Kp), Np = __builtin_amdgcn_readfirstlane(cv[ci].Np);
        const int tn = Np / 64, ntile = (Kp / 32) * tn;
        const int start = (wg - (off % nw) + nw) % nw;
        off += ntile;
        f32x4 pv[8];
#define CW_LOAD(ti_) do { const int k0_ = ((ti_) / tn) * 32, n0_ = ((ti_) % tn) * 64; _Pragma("unroll") for (int i = 0; i < 8; ++i) { \
            const int kk_ = k0_ + q + 4 * i, nn_ = n0_ + l15 * 4; pv[i] = (f32x4){0.f, 0.f, 0.f, 0.f}; \
            if (kk_ < K && nn_ < N) pv[i] = *(const GAS f32x4*)(src + (size_t)kk_ * N + nn_); } } while (0)
        if (start < ntile) CW_LOAD(start);
        for (int ti = start; ti < ntile; ti += nw) {
            const int k0 = (ti / tn) * 32, n0 = (ti % tn) * 64;
            f32x4 c[8];
#pragma unroll
            for (int i = 0; i < 8; ++i) c[i] = pv[i];
            if (ti + nw < ntile) CW_LOAD(ti + nw);
#pragma unroll
            for (int i = 0; i < 8; ++i) {
                const unsigned p01 = cvt_pk_bf16(c[i][0], c[i][1]), p23 = cvt_pk_bf16(c[i][2], c[i][3]);
                const int kl = q + 4 * i;
                tl[(l15 * 4 + 0) * 34 + kl] = (unsigned short)(p01 & 0xffffu); tl[(l15 * 4 + 1) * 34 + kl] = (unsigned short)(p01 >> 16);
                tl[(l15 * 4 + 2) * 34 + kl] = (unsigned short)(p23 & 0xffffu); tl[(l15 * 4 + 3) * 34 + kl] = (unsigned short)(p23 >> 16);
            }
            wave_fence();
            const LAS unsigned* rp = (const LAS unsigned*)(tl + lane * 34);
#pragma unroll
            for (int j = 0; j < 4; ++j) { u32x4 w; w.x = rp[4 * j + 0]; w.y = rp[4 * j + 1]; w.z = rp[4 * j + 2]; w.w = rp[4 * j + 3]; *(GAS u32x4*)(dst + (size_t)(n0 + lane) * Kp + k0 + 8 * j) = w; }
            wave_fence();
        }
#undef CW_LOAD
    }
}

__device__ __forceinline__ void phase_scan(const float* __restrict__ R, const float* __restrict__ W, const float* __restrict__ Kb, const float* __restrict__ V,
                           const float* __restrict__ AA, const float* __restrict__ k_k, float* __restrict__ Y, const float* __restrict__ k_a, const float* __restrict__ r_k,
                           float* __restrict__ BON, LAS unsigned char* lds, const LAS Conv* cv, int nconv) {
    const int wid = ltid() >> 6, lane = ltid() & 63, nb = gridDim.x;
    constexpr int CH = 16, BUF_F = CH * 320 + 64;
    volatile LAS int* flags = (volatile LAS int*)(lds + 2 * (2 * BUF_F) * 4);
    if (ltid() < 8) flags[ltid()] = 0;
    __syncthreads();
    if (wid >= 6) {
        const int widx = wid - 6;
        conv_worker(cv, nconv, (int)blockIdx.x * 2 + widx, nb * 2, (LAS unsigned short*)(lds + 2 * (2 * BUF_F) * 4 + 64) + widx * (64 * 34 + 32), lane);
        return;
    }
    if (wid >= 4) return;
    const int p = wid & 1;
    LAS float* wbase = (LAS float*)lds + p * (2 * BUF_F);
    volatile LAS int* ready = flags + p * 4; volatile LAS int* done = flags + p * 4 + 2;
    const int rl = lane >> 4, cl = lane & 15;
    for (int u = (int)blockIdx.x + nb * p; u < 512; u += nb * 2) {
        int head, rowgrp;
        if (nb == 256) { const int xcd = blockIdx.x & 7, slot = (blockIdx.x >> 3) + 32 * p; head = xcd * 4 + (slot >> 4); rowgrp = slot & 15; }
        else { head = u >> 4; rowgrp = u & 15; }
        const int cbase = head * 64, rowbase = rowgrp * 4;
        const int ubase = ((u - (int)blockIdx.x - nb * p) / (nb * 2)) * (T / CH / 2);
        if (wid >= 2) {
            const GAS float* arr[4] = {(const GAS float*)W, (const GAS float*)Kb, (const GAS float*)AA, (const GAS float*)R};
            const GAS float* Vg = (const GAS float*)V;
            const f32x4 kk4 = *(const GAS f32x4*)(k_k + cbase + cl * 4), ka4 = *(const GAS f32x4*)(k_a + cbase + cl * 4), rk4 = *(const GAS f32x4*)(r_k + cbase + cl * 4);
            f32x4 pre[16]; float prev;
#define SCAN_LOAD(t0) do { _Pragma("unroll") for (int a = 0; a < 4; ++a) _Pragma("unroll") for (int i = 0; i < 4; ++i) \
                pre[a * 4 + i] = *(const GAS f32x4*)(arr[a] + (size_t)((t0) + 4 * i + rl) * D + cbase + cl * 4); \
                prev = Vg[(size_t)((t0) + (lane >> 2)) * D + cbase + rowbase + (lane & 3)]; } while (0)
            SCAN_LOAD(0);
            for (int c = 0; c < T / CH; ++c) {
                const int b = c & 1;
                LAS float* buf = wbase + b * BUF_F;
                while (done[b] < ubase + (c >> 1)) __builtin_amdgcn_s_sleep(1);
                asm volatile("" ::: "memory");
                const int t0 = c * CH;
#pragma unroll
                for (int i = 0; i < 4; ++i) {
                    const f32x4 w_ = pre[0 + i], k_ = pre[4 + i], a_ = pre[8 + i], r_ = pre[12 + i];
                    f32x4 kk_ = k_ * kk4; const float ss_ = red16(kk_[0] * kk_[0] + kk_[1] * kk_[1] + kk_[2] * kk_[2] + kk_[3] * kk_[3]);
                    kk_ = kk_ * rsqrtf(fmaxf(ss_, 1e-24f));
                    const f32x4 kp_ = k_ * (1.f + (a_ - 1.f) * ka4); const f32x4 rk_ = r_ * kp_ * rk4;
                    const float bon_ = red16(rk_[0] + rk_[1] + rk_[2] + rk_[3]);
                    LAS float* sp_ = buf + ((4 * i + rl) * 5) * 64 + cl * 4;
                    *(LAS f32x4*)(sp_) = w_; *(LAS f32x4*)(sp_ + 64) = kp_; *(LAS f32x4*)(sp_ + 128) = -kk_; *(LAS f32x4*)(sp_ + 192) = kk_ * a_; *(LAS f32x4*)(sp_ + 256) = r_;
                    if (rowgrp == 0 && cl == 0) ((GAS float*)BON)[(size_t)(t0 + 4 * i + rl) * 32 + head] = bon_;
                }
                buf[CH * 320 + lane] = prev;
                if (c + 1 < T / CH) SCAN_LOAD((c + 1) * CH);
                asm volatile("s_waitcnt lgkmcnt(0)" ::: "memory");
                if (lane == 0) ready[b] = ubase + (c >> 1) + 1;
            }
#undef SCAN_LOAD
        } else {
            GAS float* Yg = (GAS float*)Y;
            f32x4 S = {0.f, 0.f, 0.f, 0.f};
            for (int c = 0; c < T / CH; ++c) {
                const int b = c & 1;
                LAS float* cur = wbase + b * BUF_F;
                while (ready[b] < ubase + (c >> 1) + 1) __builtin_amdgcn_s_sleep(1);
                asm volatile("" ::: "memory");
                float yacc = 0.f;
                f32x4 w4, k4, a4, b4, r4; float v;
#define SCAN_RD(s_) do { const LAS float* sp = cur + (s_) * 320 + cl * 4; w4 = *(const LAS f32x4*)(sp); k4 = *(const LAS f32x4*)(sp + 64); a4 = *(const LAS f32x4*)(sp + 128); \
                    b4 = *(const LAS f32x4*)(sp + 192); r4 = *(const LAS f32x4*)(sp + 256); v = cur[CH * 320 + (s_) * 4 + rl]; } while (0)
                SCAN_RD(0);
                f32x4 pr = r4;
#pragma unroll
                for (int s = 0; s < CH; ++s) {
                    const f32x4 cw = w4, ck = k4, ca = a4, cb = b4, cr = r4; const float cv = v;
                    if (s + 1 < CH) SCAN_RD(s + 1);
                    __builtin_amdgcn_sched_barrier(0);
                    f32x2v ta = (f32x2v){S[0], S[1]} * (f32x2v){ca[0], ca[1]}; ta = (f32x2v){S[2], S[3]} * (f32x2v){ca[2], ca[3]} + ta;
                    f32x2v ty = (f32x2v){S[0], S[1]} * (f32x2v){pr[0], pr[1]}; ty = (f32x2v){S[2], S[3]} * (f32x2v){pr[2], pr[3]} + ty;
                    float sa = ta[0] + ta[1];
                    float y = ty[0] + ty[1];
                    const f32x4 cc = S * cw + cv * ck;
                    sa += dpp_f<0xB1>(sa); y += dpp_f<0xB1>(y);
                    sa += dpp_f<0x4E>(sa); y += dpp_f<0x4E>(y);
                    sa += dpp_f<0x141>(sa); y += dpp_f<0x141>(y);
                    sa += dpp_f<0x140>(sa); y += dpp_f<0x140>(y);
                    S = sa * cb + cc;
                    if (s > 0) yacc = (cl == s - 1) ? y : yacc;
                    pr = cr;
                    if (s == CH - 1) { asm volatile("s_waitcnt lgkmcnt(0)" ::: "memory"); if (lane == 0) done[b] = ubase + (c >> 1) + 1; }
                }
                {
                    float y = S[0] * pr[0] + S[1] * pr[1] + S[2] * pr[2] + S[3] * pr[3];
                    y = red16(y);
                    yacc = (cl == CH - 1) ? y : yacc;
                }
#undef SCAN_RD
                Yg[(size_t)(c * CH + cl) * D + cbase + rowbase + rl] = yacc;
            }
        }
    }
}

enum { EP_F32 = 0, EP_BF16, EP_TANH, EP_SIGM, EP_RELU2, EP_RESID, EP_DECAY, EP_SIGB, EP_VMIX, EP_Q, EP_GELU };
struct Job { const bf16_t* A; const bf16_t* Bt; void* out; const float* aux; const float* aux2; int nM, nN, ldc, mode, ustart, pad0; };
struct Unit { int pm, pn, job; };
constexpr int BM = 256, BK = 64, HALF = 128, HTB = HALF * BK * 2;
__device__ __forceinline__ int lds_byte(int r, int c) { const int st = (r >> 4) * 2 + (c >> 5), rr = r & 15, cc = c & 31, ob = rr * 64 + cc * 2; return st * 1024 + (ob ^ (((ob >> 9) & 1) << 5)); }
__device__ __forceinline__ void stage_rc(int b, int& R, int& C) { const int st = b / 1024, sb = b % 1024, swz = sb ^ (((sb >> 9) & 1) << 5); R = (st >> 1) * 16 + swz / 64; C = (st & 1) * 32 + (swz % 64) / 2; }

__device__ __forceinline__ bool next_unit(const LAS Job* jobs, int nj, int total, int i, Unit& u) {
    const long L = (long)i * gridDim.x + blockIdx.x;
    if (L >= total) return false;
    int j = 0;
    for (int q = 1; q < nj; ++q) if ((int)L >= jobs[q].ustart) j = q;
    const int nM = jobs[j].nM, nN = jobs[j].nN, nwg = nM * nN;
    int wgid = (int)L - jobs[j].ustart;
    { const int q = nwg / 8, r = nwg % 8, xcd = wgid % 8, off = wgid / 8; wgid = (xcd < r ? xcd * (q + 1) : r * (q + 1) + (xcd - r) * q) + off; }
    const int nig = 8 * nN, gid = wgid / nig, fm = gid * 8, gsz = (nM - fm) < 8 ? (nM - fm) : 8;
    u.pm = __builtin_amdgcn_readfirstlane(fm + ((wgid % nig) % gsz));
    u.pn = __builtin_amdgcn_readfirstlane((wgid % nig) / gsz);
    u.job = __builtin_amdgcn_readfirstlane(j);
    return true;
}

template <int MODE>
__device__ __forceinline__ void epi_t(const f32x4 (&acc)[2][2][4][2], void* outp, int ldc, const float* aux, const float* aux2, int pm, int pn, int wr, int wc, int fr, int fq) {
    const int row0 = pm * BM + wr * 64 + fr, col0 = pn * BM + wc * 32 + 4 * fq;
#pragma unroll
    for (int ai = 0; ai < 2; ++ai)
#pragma unroll
        for (int m = 0; m < 4; ++m) {
            const size_t row = (size_t)(row0 + ai * HALF + m * 16);
#pragma unroll
            for (int bj = 0; bj < 2; ++bj)
#pragma unroll
                for (int n = 0; n < 2; ++n) {
                    const int col = col0 + bj * HALF + n * 16;
                    f32x4 v = acc[ai][bj][m][n];
                    const size_t o = row * (size_t)ldc + col;
                    if constexpr (MODE == EP_F32) { *(f32x4*)((float*)outp + o) = v; }
                    else if constexpr (MODE == EP_BF16) { store_bf4((bf16_t*)outp + o, v); }
                    else if constexpr (MODE == EP_TANH) { v[0] = tanhf_(v[0]); v[1] = tanhf_(v[1]); v[2] = tanhf_(v[2]); v[3] = tanhf_(v[3]); store_bf4((bf16_t*)outp + o, v); }
                    else if constexpr (MODE == EP_SIGM) { v[0] = sigmoidf_(v[0]); v[1] = sigmoidf_(v[1]); v[2] = sigmoidf_(v[2]); v[3] = sigmoidf_(v[3]); store_bf4((bf16_t*)outp + o, v); }
                    else if constexpr (MODE == EP_RELU2) { v[0] = fmaxf(v[0], 0.f); v[1] = fmaxf(v[1], 0.f); v[2] = fmaxf(v[2], 0.f); v[3] = fmaxf(v[3], 0.f); store_bf4((bf16_t*)outp + o, v * v); }
                    else if constexpr (MODE == EP_RESID) { f32x4* hp = (f32x4*)((float*)outp + o); *hp = *hp + v; }
                    else if constexpr (MODE == EP_DECAY) {
                        const f32x4 x = v + *(const f32x4*)(aux + col);
#pragma unroll
                        for (int j = 0; j < 4; ++j) { const float z = -x[j]; const float sp = fmaxf(z, 0.f) + log1pf(__expf(-fabsf(z))); v[j] = __expf(-__expf(-sp - 0.5f)); }
                        *(f32x4*)((float*)outp + o) = v;
                    }
                    else if constexpr (MODE == EP_SIGB) {
                        const f32x4 x = v + *(const f32x4*)(aux + col);
                        v[0] = sigmoidf_(x[0]); v[1] = sigmoidf_(x[1]); v[2] = sigmoidf_(x[2]); v[3] = sigmoidf_(x[3]);
                        *(f32x4*)((float*)outp + o) = v;
                    }
                    else if constexpr (MODE == EP_VMIX) {
                        const f32x4 x = v + *(const f32x4*)(aux + col);
                        const f32x4 vf = *(const f32x4*)(aux2 + o); f32x4 vv = *(const f32x4*)((float*)outp + o);
#pragma unroll
                        for (int j = 0; j < 4; ++j) vv[j] = vv[j] + (vf[j] - vv[j]) * sigmoidf_(x[j]);
                        *(f32x4*)((float*)outp + o) = vv;
                    }
                    else if constexpr (MODE == EP_Q) {
                        if (col < 2048) { store_bf4((bf16_t*)outp + row * 2048 + col, v * 0.08838834764831845f); }
                        else if (col < 2096) { v[0] = sigmoidf_(v[0]); v[1] = sigmoidf_(v[1]); v[2] = sigmoidf_(v[2]); v[3] = sigmoidf_(v[3]); *(f32x4*)((float*)aux + row * 48 + (col - 2048)) = v; }
                    }
                    else if constexpr (MODE == EP_GELU) {
                        const f32x4 x = v + *(const f32x4*)(aux + col);
#pragma unroll
                        for (int j = 0; j < 4; ++j) { const float xx = x[j]; v[j] = 0.5f * xx * (1.f + tanhf_(0.7978845608028654f * (xx + 0.044715f * xx * xx * xx))); }
                        store_bf4((bf16_t*)outp + o, v);
                    }
                }
        }
}
__device__ __forceinline__ void epilogue(const f32x4 (&acc)[2][2][4][2], const LAS Job* jb, int pm, int pn, int wr, int wc, int fr, int fq) {
    void* outp = jb->out; const int ldc = jb->ldc, mode = __builtin_amdgcn_readfirstlane(jb->mode); const float* aux = jb->aux; const float* aux2 = jb->aux2;
    switch (mode) {
        case EP_F32: epi_t<EP_F32>(acc, outp, ldc, aux, aux2, pm, pn, wr, wc, fr, fq); break;
        case EP_BF16: epi_t<EP_BF16>(acc, outp, ldc, aux, aux2, pm, pn, wr, wc, fr, fq); break;
        case EP_TANH: epi_t<EP_TANH>(acc, outp, ldc, aux, aux2, pm, pn, wr, wc, fr, fq); break;
        case EP_SIGM: epi_t<EP_SIGM>(acc, outp, ldc, aux, aux2, pm, pn, wr, wc, fr, fq); break;
        case EP_RELU2: epi_t<EP_RELU2>(acc, outp, ldc, aux, aux2, pm, pn, wr, wc, fr, fq); break;
        case EP_RESID: epi_t<EP_RESID>(acc, outp, ldc, aux, aux2, pm, pn, wr, wc, fr, fq); break;
        case EP_DECAY: epi_t<EP_DECAY>(acc, outp, ldc, aux, aux2, pm, pn, wr, wc, fr, fq); break;
        case EP_SIGB: epi_t<EP_SIGB>(acc, outp, ldc, aux, aux2, pm, pn, wr, wc, fr, fq); break;
        case EP_VMIX: epi_t<EP_VMIX>(acc, outp, ldc, aux, aux2, pm, pn, wr, wc, fr, fq); break;
        case EP_Q: epi_t<EP_Q>(acc, outp, ldc, aux, aux2, pm, pn, wr, wc, fr, fq); break;
        default: epi_t<EP_GELU>(acc, outp, ldc, aux, aux2, pm, pn, wr, wc, fr, fq); break;
    }
}

__device__ __forceinline__ void gemm_phase(LAS unsigned char* lds, const LAS Job* jobs, int nj, int total, int K, int lda, int ldb) {
    const int tid = ltid(), wid = __builtin_amdgcn_readfirstlane(tid >> 6), lane = tid & 63, wr = wid >> 2, wc = wid & 3, fr = lane & 15, fq = lane >> 4;
    const int nt = K / BK;
    unsigned voffA[2], voffB[2];
#pragma unroll
    for (int i = 0; i < 2; ++i) { int R, C; stage_rc(tid * 16 + i * 8192, R, C); voffA[i] = (unsigned)(R * lda + C) * 2u; voffB[i] = (unsigned)(R * ldb + C) * 2u; }
    const size_t kstep = (size_t)(BK * 2);
    const size_t hstepA = (size_t)HALF * lda * 2, hstepB = (size_t)HALF * ldb * 2;
    const size_t tstepA = 2 * hstepA, tstepB = 2 * hstepB;
    const unsigned ldsw = (unsigned)wid * 1024u;
    const int aoff = lds_byte(wr * 64 + fr, fq * 8), boff = lds_byte(wc * 32 + fr, fq * 8);
#define PG8_SA(b, h) (((b) * 2 + (h)) * HTB)
#define PG8_SB(b, h) ((4 + (b) * 2 + (h)) * HTB)
#define PG8_STAGE(bufoff, gbase, voff) do { _Pragma("unroll") for (int _i = 0; _i < 2; ++_i) \
        __builtin_amdgcn_global_load_lds((const unsigned*)((const char*)(gbase) + (voff)[_i]), (LAS unsigned*)(lds + (bufoff) + ldsw + _i * 8192), 16, 0, 0); } while (0)
#define PG8_LDA(dst, b, h) do { _Pragma("unroll") for (int m = 0; m < 4; ++m) _Pragma("unroll") for (int k = 0; k < 2; ++k) dst[m][k] = *(const LAS bf16x8*)(lds + PG8_SA(b, h) + aoff + m * 2048 + k * 1024); } while (0)
#define PG8_LDB(dst, b, h) do { _Pragma("unroll") for (int n = 0; n < 2; ++n) _Pragma("unroll") for (int k = 0; k < 2; ++k) dst[n][k] = *(const LAS bf16x8*)(lds + PG8_SB(b, h) + boff + n * 2048 + k * 1024); } while (0)
#define PG8_MMA(ai, bj, At, Bt) do { __builtin_amdgcn_s_setprio(1); _Pragma("unroll") for (int m = 0; m < 4; ++m) _Pragma("unroll") for (int n = 0; n < 2; ++n) _Pragma("unroll") for (int k = 0; k < 2; ++k) \
        acc[ai][bj][m][n] = __builtin_amdgcn_mfma_f32_16x16x32_bf16(Bt[n][k], At[m][k], acc[ai][bj][m][n], 0, 0, 0); __builtin_amdgcn_s_setprio(0); } while (0)
#define PG8_WAIT_V(n) asm volatile("s_waitcnt vmcnt(" #n ")" ::: "memory")
#define PG8_WAIT_L(n) asm volatile("s_waitcnt lgkmcnt(" #n ")" ::: "memory")
#define PG8_BAR __builtin_amdgcn_s_barrier()
#define PG8_SCHED __builtin_amdgcn_sched_barrier(0)
    Unit cur, nxt; int ui = 0;
    if (!next_unit(jobs, nj, total, 0, cur)) return;
    f32x4 acc[2][2][4][2];
#pragma unroll
    for (int a = 0; a < 2; ++a)
#pragma unroll
        for (int b = 0; b < 2; ++b)
#pragma unroll
            for (int m = 0; m < 4; ++m)
#pragma unroll
                for (int n = 0; n < 2; ++n) acc[a][b][m][n] = (f32x4){0.f, 0.f, 0.f, 0.f};
    bf16x8 At[4][2], B0[2][2], B1[2][2];
    const char* cA = (const char*)jobs[cur.job].A + (size_t)cur.pm * tstepA; const char* cB = (const char*)jobs[cur.job].Bt + (size_t)cur.pn * tstepB;
    PG8_STAGE(PG8_SB(0, 0), cB, voffB); PG8_STAGE(PG8_SA(0, 0), cA, voffA); PG8_STAGE(PG8_SB(0, 1), cB + hstepB, voffB); PG8_STAGE(PG8_SA(0, 1), cA + hstepA, voffA);
    if (wr == 1) PG8_BAR;
    PG8_WAIT_V(4); PG8_BAR;
    PG8_STAGE(PG8_SB(1, 0), cB + kstep, voffB); PG8_STAGE(PG8_SA(1, 0), cA + kstep, voffA); PG8_STAGE(PG8_SB(1, 1), cB + hstepB + kstep, voffB);
    PG8_WAIT_V(6); PG8_BAR;
    for (;;) {
        const bool has_next = next_unit(jobs, nj, total, ui + 1, nxt);
        const char* nA = has_next ? (const char*)jobs[nxt.job].A + (size_t)nxt.pm * tstepA : cA; const char* nB = has_next ? (const char*)jobs[nxt.job].Bt + (size_t)nxt.pn * tstepB : cB;
        for (int t = 0; t < nt; t += 2) {
            const bool last = (t == nt - 2);
            const char* a1 = cA + (size_t)(t + 1) * kstep;
            const char* a2 = last ? nA : cA + (size_t)(t + 2) * kstep; const char* b2 = last ? nB : cB + (size_t)(t + 2) * kstep;
            const char* a3 = a2 + kstep; const char* b3 = b2 + kstep;
            PG8_LDB(B0, 0, 0); PG8_SCHED; PG8_LDA(At, 0, 0); PG8_STAGE(PG8_SA(1, 1), a1 + hstepA, voffA);
            PG8_WAIT_L(8); PG8_BAR; PG8_WAIT_L(0); PG8_MMA(0, 0, At, B0); PG8_BAR; PG8_SCHED;
            PG8_LDB(B1, 0, 1); PG8_STAGE(PG8_SB(0, 0), b2, voffB);
            PG8_BAR; PG8_WAIT_L(0); PG8_MMA(0, 1, At, B1); PG8_BAR;
            PG8_LDA(At, 0, 1); PG8_STAGE(PG8_SA(0, 0), a2, voffA);
            PG8_BAR; PG8_WAIT_L(0); PG8_MMA(1, 0, At, B0); PG8_BAR; PG8_SCHED;
            PG8_STAGE(PG8_SB(0, 1), b2 + hstepB, voffB);
            PG8_WAIT_V(6); PG8_BAR; PG8_MMA(1, 1, At, B1); PG8_BAR;
            PG8_LDB(B0, 1, 0); PG8_SCHED; PG8_LDA(At, 1, 0); PG8_STAGE(PG8_SA(0, 1), a2 + hstepA, voffA);
            PG8_WAIT_L(8); PG8_BAR; PG8_WAIT_L(0); PG8_MMA(0, 0, At, B0); PG8_BAR; PG8_SCHED;
            PG8_LDB(B1, 1, 1); PG8_STAGE(PG8_SB(1, 0), b3, voffB);
            PG8_BAR; PG8_WAIT_L(0); PG8_MMA(0, 1, At, B1); PG8_BAR;
            PG8_LDA(At, 1, 1); PG8_STAGE(PG8_SA(1, 0), a3, voffA);
            PG8_BAR; PG8_WAIT_L(0); PG8_MMA(1, 0, At, B0); PG8_BAR; PG8_SCHED;
            PG8_STAGE(PG8_SB(1, 1), b3 + hstepB, voffB);
            PG8_WAIT_V(6); PG8_BAR; PG8_MMA(1, 1, At, B1); PG8_BAR;
        }
        epilogue(acc, jobs + cur.job, cur.pm, cur.pn, wr, wc, fr, fq);
        if (!has_next) break;
#pragma unroll
        for (int a = 0; a < 2; ++a)
#pragma unroll
            for (int b = 0; b < 2; ++b)
#pragma unroll
                for (int m = 0; m < 4; ++m)
#pragma unroll
                    for (int n = 0; n < 2; ++n) acc[a][b][m][n] = (f32x4){0.f, 0.f, 0.f, 0.f};
        cur = nxt; cA = nA; cB = nB; ++ui;
    }
    PG8_WAIT_V(0);
    if (wr == 0) PG8_BAR;
    PG8_BAR;
#undef PG8_SA
#undef PG8_SB
#undef PG8_STAGE
#undef PG8_LDA
#undef PG8_LDB
#undef PG8_MMA
#undef PG8_WAIT_V
#undef PG8_WAIT_L
#undef PG8_BAR
#undef PG8_SCHED
}

__device__ __forceinline__ int t5_bucket_dev(int n) { if (n < 16) return n; int b = 16 + (int)(logf((float)n * 0.0625f) / 2.0794415416798357f * 16.0f); return b > 31 ? 31 : b; }

constexpr int KROW = 272, VROW = 144, KTILE_B = 64 * KROW, VTILE_B = 128 * VROW;
template <int BR, int NT>
__device__ __forceinline__ void flash_chunk(const bool FAST, const bf16x8 (&qf)[NT][4], float (&m)[NT], float (&l)[NT], f32x4 (&O)[NT][8], const LAS unsigned char* kl, const LAS unsigned char* vl,
                                            const int (&t)[NT], int key0, const LAS float* mylut, const bool (&selbit)[NT], float inv_l, volatile LAS float* myimp, int lane) {
    const int tok = lane & 15, q = lane >> 4;
    f32x4 S[NT][4];
#pragma unroll
    for (int mt = 0; mt < 4; ++mt) {
#pragma unroll
        for (int nt = 0; nt < NT; ++nt) S[nt][mt] = (f32x4){0.f, 0.f, 0.f, 0.f};
        const LAS unsigned char* kr = kl + (mt * 16 + tok) * KROW + q * 16;
#pragma unroll
        for (int kk = 0; kk < 4; ++kk) {
            const bf16x8 a = *(const LAS bf16x8*)(kr + kk * 64);
#pragma unroll
            for (int nt = 0; nt < NT; ++nt) S[nt][mt] = __builtin_amdgcn_mfma_f32_16x16x32_bf16(a, qf[nt][kk], S[nt][mt], 0, 0, 0);
        }
    }
#pragma unroll
    for (int nt = 0; nt < NT; ++nt) {
        float mx = -1e30f;
        if (FAST) {
            const float cbias = mylut[128];
#pragma unroll
            for (int mt = 0; mt < 4; ++mt)
#pragma unroll
                for (int j = 0; j < 4; ++j) { const float s = S[nt][mt][j] + cbias; S[nt][mt][j] = s; mx = fmaxf(mx, s); }
            if (BR == 2 && !selbit[nt]) mx = -1e30f;
        } else {
#pragma unroll
            for (int mt = 0; mt < 4; ++mt)
#pragma unroll
                for (int j = 0; j < 4; ++j) {
                    const int kidx = mt * 16 + q * 4 + j; int dist; bool v;
                    if (BR <= 1) { dist = t[nt] - (16 * (key0 + kidx) + 31); v = dist >= 0; }
                    else if (BR == 2) { dist = t[nt] - (key0 + kidx); v = (dist >= 0) && selbit[nt]; }
                    else { dist = t[nt] - (key0 + kidx); v = (dist >= 0) && (dist < 512); }
                    const int di = dist < 0 ? 0 : (dist > 128 ? 128 : dist);
                    float s = S[nt][mt][j] + mylut[di];
                    s = v ? s : -1e30f; S[nt][mt][j] = s; mx = fmaxf(mx, s);
                }
        }
        float mnew, alpha;
        if (BR == 1) { mnew = m[nt]; alpha = 1.f; }
        else { mx = xmax4(mx); mnew = fmaxf(m[nt], mx); alpha = __expf(m[nt] - mnew); }
        float rs = 0.f;
        if (FAST) {
            const bool v = (BR != 2) || selbit[nt];
#pragma unroll
            for (int mt = 0; mt < 4; ++mt)
#pragma unroll
                for (int j = 0; j < 4; ++j) { const float p = v ? __expf(S[nt][mt][j] - mnew) : 0.f; S[nt][mt][j] = p; rs += p; }
        } else {
#pragma unroll
            for (int mt = 0; mt < 4; ++mt)
#pragma unroll
                for (int j = 0; j < 4; ++j) { const float s = S[nt][mt][j]; const float p = (s > -1e29f) ? __expf(s - mnew) : 0.f; S[nt][mt][j] = p; rs += p; }
        }
        rs = xsum4(rs);
        l[nt] = l[nt] * alpha + rs; m[nt] = mnew;
        if (BR >= 2) {
            if (__ballot(alpha != 1.f) != 0ull) {
#pragma unroll
                for (int dt = 0; dt < 8; ++dt) O[nt][dt] = O[nt][dt] * alpha;
            }
        }
    }
    if (BR == 0) return;
    if (BR == 1) {
        const int u0 = tok * 132 + (key0 >> 2) + q;
#pragma unroll
        for (int mt = 0; mt < 4; ++mt) { const float s4 = (S[0][mt][0] + S[0][mt][1] + S[0][mt][2] + S[0][mt][3]) * inv_l; myimp[u0 + mt * 4] = myimp[u0 + mt * 4] + s4; }
        wave_fence();
#pragma unroll
        for (int mt = 0; mt < 4; ++mt) { const float p3 = S[0][mt][3] * inv_l; myimp[u0 + mt * 4 + 1] = myimp[u0 + mt * 4 + 1] + p3; }
        wave_fence();
    }
#pragma unroll
    for (int i = 0; i < 2; ++i) {
        union { u32x4 u; bf16x8 b; } pb[NT];
#pragma unroll
        for (int nt = 0; nt < NT; ++nt) {
            pb[nt].u.x = cvt_pk_bf16(S[nt][2 * i][0], S[nt][2 * i][1]); pb[nt].u.y = cvt_pk_bf16(S[nt][2 * i][2], S[nt][2 * i][3]);
            pb[nt].u.z = cvt_pk_bf16(S[nt][2 * i + 1][0], S[nt][2 * i + 1][1]); pb[nt].u.w = cvt_pk_bf16(S[nt][2 * i + 1][2], S[nt][2 * i + 1][3]);
        }
#pragma unroll
        for (int dt = 0; dt < 8; ++dt) {
            const LAS unsigned char* vr = vl + (dt * 16 + tok) * VROW + (32 * i + 4 * q) * 2;
            union { struct { u32x2 lo, hi; } s; bf16x8 b; } va;
            va.s.lo = *(const LAS u32x2*)vr; va.s.hi = *(const LAS u32x2*)(vr + 32);
#pragma unroll
            for (int nt = 0; nt < NT; ++nt) O[nt][dt] = __builtin_amdgcn_mfma_f32_16x16x32_bf16(va.b, pb[nt].b, O[nt][dt], 0, 0, 0);
        }
    }
}
__device__ __forceinline__ void kv_load(u32x4 (&r)[4], const bf16_t* __restrict__ kb, int kstride, const bf16_t* __restrict__ vb, int vtstride, bool needv, int tid) {
#pragma unroll
    for (int j = 0; j < 2; ++j) { const unsigned p = (unsigned)tid + 512u * j; const unsigned off = (p >> 4) * (unsigned)kstride + (p & 15u) * 8u; r[j] = *(const GAS u32x4*)(kb + off); }
    if (needv) {
#pragma unroll
        for (int j = 0; j < 2; ++j) { const unsigned p = (unsigned)tid + 512u * j; const unsigned off = (p >> 3) * (unsigned)vtstride + (p & 7u) * 8u; r[2 + j] = *(const GAS u32x4*)(vb + off); }
    }
}
__device__ __forceinline__ void kv_store(const u32x4 (&r)[4], LAS unsigned char* kl, LAS unsigned char* vl, bool needv, int tid) {
#pragma unroll
    for (int j = 0; j < 2; ++j) { const int p = tid + 512 * j; *(LAS u32x4*)(kl + (p >> 4) * KROW + (p & 15) * 16) = r[j]; }
    if (needv) {
#pragma unroll
        for (int j = 0; j < 2; ++j) { const int p = tid + 512 * j; *(LAS u32x4*)(vl + (p >> 3) * VROW + (p & 7) * 16) = r[2 + j]; }
    }
}
template <int BR, int NT>
__device__ __forceinline__ void branch_step(int i, int n, const LAS int* clist, const bf16_t* __restrict__ kbase0, int kstride, const bf16_t* __restrict__ vbase0, int vtstride,
                                            const bf16x8 (&qf)[NT][4], float (&m)[NT], float (&l)[NT], f32x4 (&O)[NT][8], const int (&t)[NT], int t0w, const LAS float* mylut, const LAS unsigned* mymask,
                                            float inv_l, volatile LAS float* myimp, LAS unsigned char* ck, LAS unsigned char* cv, LAS unsigned char* nk, LAS unsigned char* nv, int tid, int lane) {
    u32x4 r[4];
    const int c = __builtin_amdgcn_readfirstlane(clist[i]);
    if (i + 1 < n) { const int cn = __builtin_amdgcn_readfirstlane(clist[i + 1]); kv_load(r, kbase0 + (size_t)cn * 64 * kstride, kstride, vbase0 + cn * 64, vtstride, BR != 0, tid); }
    bool bit[NT]; bool any = true;
    if (BR == 2) {
        any = false;
#pragma unroll
        for (int nt = 0; nt < NT; ++nt) { const unsigned w = mymask[nt * 64 + (c >> 5)]; bit[nt] = (w >> (c & 31)) & 1u; any = any || bit[nt]; }
    } else {
#pragma unroll
        for (int nt = 0; nt < NT; ++nt) bit[nt] = true;
    }
    if (BR != 2 || __ballot(any) != 0ull) {
        bool far = false;
        if (BR <= 1) far = (t0w - (16 * (c * 64 + 63) + 31)) >= 128;
        else if (BR == 2) far = (t0w - (c * 64 + 63)) >= 128;
        flash_chunk<BR, NT>(far, qf, m, l, O, ck, cv, t, c * 64, mylut, bit, inv_l, myimp, lane);
    }
    if (BR >= 2) {
        if (i + 1 < n) kv_store(r, nk, nv, true, tid);
        __syncthreads();
    } else {
        __syncthreads();
        if (i + 1 < n) kv_store(r, nk, nv, BR != 0, tid);
        __syncthreads();
    }
}
template <int BR, int NT>
__device__ __forceinline__ void run_branch(const LAS int* clist, int n, const bf16_t* __restrict__ kbase0, int kstride, const bf16_t* __restrict__ vbase0, int vtstride,
                                           const bf16x8 (&qf)[NT][4], float (&m)[NT], float (&l)[NT], f32x4 (&O)[NT][8], const int (&t)[NT], const LAS float* mylut, const LAS unsigned* mymask,
                                           float inv_l, volatile LAS float* myimp, LAS unsigned char* kl, LAS unsigned char* vl, LAS unsigned char* kl1, LAS unsigned char* vl1, int tid, int lane) {
    if (n == 0) return;
    asm volatile("" : "+v"(tid), "+v"(lane));
    {
        u32x4 r[4];
        const int c = clist[0];
        kv_load(r, kbase0 + (size_t)c * 64 * kstride, kstride, vbase0 + c * 64, vtstride, BR != 0, tid);
        kv_store(r, kl, vl, BR != 0, tid);
    }
    __syncthreads();
    const int t0w = __builtin_amdgcn_readfirstlane(t[0]);
    if (BR >= 2) {
        for (int i = 0; i < n; i += 2) {
            branch_step<BR, NT>(i, n, clist, kbase0, kstride, vbase0, vtstride, qf, m, l, O, t, t0w, mylut, mymask, inv_l, myimp, kl, vl, kl1, vl1, tid, lane);
            if (i + 1 < n) branch_step<BR, NT>(i + 1, n, clist, kbase0, kstride, vbase0, vtstride, qf, m, l, O, t, t0w, mylut, mymask, inv_l, myimp, kl1, vl1, kl, vl, tid, lane);
        }
    } else {
        for (int i = 0; i < n; ++i)
            branch_step<BR, NT>(i, n, clist, kbase0, kstride, vbase0, vtstride, qf, m, l, O, t, t0w, mylut, mymask, inv_l, myimp, kl, vl, kl, vl, tid, lane);
    }
}

__device__ __forceinline__ void phase_attn(const bf16_t* __restrict__ Q, const float* __restrict__ GATES, const bf16_t* __restrict__ KV, const bf16_t* __restrict__ VTS,
                           const bf16_t* __restrict__ VTW, const bf16_t* __restrict__ KC, const bf16_t* __restrict__ VCT, const float* __restrict__ relb,
                           bf16_t* __restrict__ Oo, LAS unsigned char* lds) {
    LAS float* lut = (LAS float*)lds;
    LAS float* impw = lut + 4 * 132;
    LAS float* comb = impw + 8 * 16 * 132;
    LAS unsigned* selm = (LAS unsigned*)(comb + 8 * 128);
    LAS int* clist = (LAS int*)(selm + 64 * 4);
    LAS unsigned char* kl = (LAS unsigned char*)(clist + 128);
    LAS unsigned char* vl = kl + KTILE_B;
    LAS unsigned char* kl1 = (LAS unsigned char*)impw;
    LAS unsigned char* vl1 = kl1 + KTILE_B;
    for (int idx = blockIdx.x; idx < 512; idx += gridDim.x) {
        const int tid = ltid(), wid = tid >> 6, lane = tid & 63, r = wid & 3, sub = wid >> 2, tok = lane & 15, q = lane >> 4;
        LAS float* myimp = impw + wid * 16 * 132;
        const LAS float* mylut = lut + r * 132;
        const int g = idx & 3, jj = idx >> 2, tt = (jj < 64) ? 127 - jj : jj - 64, h = g * 4 + r;
        __syncthreads();
        for (int e = tid; e < 4 * 129; e += 512) { const int rr = e / 129, n = e % 129; lut[rr * 132 + n] = relb[t5_bucket_dev(n) * 16 + g * 4 + rr]; }
        for (int half = 0; half < 2; ++half) {
            const int tt32 = tt * 2 + half;
            int t1[1]; t1[0] = tt32 * 32 + sub * 16 + tok;
            const int t = t1[0];
            __syncthreads();
            for (int e = lane; e < 16 * 132; e += 64) myimp[e] = 0.f;
            const int nch = ((2 * tt32) >> 6) + 1;
            if (tid < 128) clist[tid] = tid;
            __syncthreads();
            bf16x8 qf[1][4];
#pragma unroll
            for (int kk = 0; kk < 4; ++kk) qf[0][kk] = *(const bf16x8*)(Q + (size_t)t * 2048 + h * 128 + kk * 32 + q * 8);
            f32x4 O[1][8]; float m[1], l[1];
            m[0] = -1e30f; l[0] = 0.f;
            run_branch<0, 1>(clist, nch, KC + (size_t)(g * 512) * 256, 256, VCT + g * 512, 2048, qf, m, l, O, t1, mylut, nullptr, 0.f, myimp, kl, vl, kl1, vl1, tid, lane);
            const float inv_l = l[0] > 0.f ? 1.f / l[0] : 0.f;
            l[0] = 0.f;
#pragma unroll
            for (int dt = 0; dt < 8; ++dt) O[0][dt] = (f32x4){0.f, 0.f, 0.f, 0.f};
            run_branch<1, 1>(clist, nch, KC + (size_t)(g * 512) * 256, 256, VCT + g * 512, 2048, qf, m, l, O, t1, mylut, nullptr, inv_l, myimp, kl, vl, kl1, vl1, tid, lane);
            { const float g0 = GATES[(size_t)t * 48 + g * 12 + r * 3 + 0];
#pragma unroll
              for (int dt = 0; dt < 8; ++dt) store_bf4(Oo + (size_t)t * 2048 + h * 128 + dt * 16 + q * 4, O[0][dt] * (inv_l * g0)); }
            __syncthreads();
            {
                LAS float* cb = comb + wid * 128;
                for (int i = 0; i < 4; ++i) {
                    const int tk = wid * 4 + i, sb = tk >> 4, row = tk & 15, tq = tt32 * 32 + tk, cur = tq >> 6;
                    float v0 = 0.f, v1 = 0.f;
#pragma unroll
                    for (int rr = 0; rr < 4; ++rr) { const LAS float* ip = impw + ((sb * 4 + rr) * 16 + row) * 132; v0 += ip[lane]; v1 += ip[lane + 64]; }
                    cb[lane] = v0; cb[lane + 64] = v1;
                    wave_fence();
                    bool sel0, sel1;
                    if (cur + 1 <= 16) { sel0 = lane <= cur; sel1 = false; }
                    else {
                        int cnt0 = 0, cnt1 = 0;
                        for (int s2 = 1; s2 < cur; ++s2) {
                            const float x = ((volatile LAS float*)cb)[s2];
                            cnt0 += ((x > v0) || (x == v0 && s2 < lane)) ? 1 : 0;
                            cnt1 += ((x > v1) || (x == v1 && s2 < lane + 64)) ? 1 : 0;
                        }
                        const int s0 = lane, s1 = lane + 64;
                        sel0 = (s0 == 0) || (s0 == cur) || (s0 < cur && cnt0 < 14);
                        sel1 = (s1 == cur) || (s1 < cur && cnt1 < 14);
                    }
                    const unsigned long long b0 = __ballot(sel0), b1 = __ballot(sel1);
                    const int ts = half * 32 + tk;
                    if (lane == 0) { selm[ts * 4 + 0] = (unsigned)b0; selm[ts * 4 + 1] = (unsigned)(b0 >> 32); selm[ts * 4 + 2] = (unsigned)b1; selm[ts * 4 + 3] = (unsigned)(b1 >> 32); }
                    wave_fence();
                }
            }
        }
        __syncthreads();
        const int smax = tt;
        if (tid == 0) {
            unsigned u0 = 0, u1 = 0, u2 = 0, u3 = 0;
            for (int k = 0; k < 64; ++k) { u0 |= selm[k * 4 + 0]; u1 |= selm[k * 4 + 1]; u2 |= selm[k * 4 + 2]; u3 |= selm[k * 4 + 3]; }
            int n = 0;
            for (int s = 0; s <= smax; ++s) { const unsigned w = s < 32 ? u0 : (s < 64 ? u1 : (s < 96 ? u2 : u3)); if ((w >> (s & 31)) & 1u) clist[n++] = s; }
            clist[127] = n;
        }
        __syncthreads();
        const int nsel = clist[127];
        {
            const int th = sub;
            int t2[2]; t2[0] = tt * 64 + th * 32 + tok; t2[1] = t2[0] + 16;
            bf16x8 qf[2][4];
#pragma unroll
            for (int nt = 0; nt < 2; ++nt)
#pragma unroll
                for (int kk = 0; kk < 4; ++kk) qf[nt][kk] = *(const bf16x8*)(Q + (size_t)t2[nt] * 2048 + h * 128 + kk * 32 + q * 8);
            f32x4 O[2][8]; float m[2], l[2];
            m[0] = -1e30f; m[1] = -1e30f; l[0] = 0.f; l[1] = 0.f;
#pragma unroll
            for (int nt = 0; nt < 2; ++nt)
#pragma unroll
                for (int dt = 0; dt < 8; ++dt) O[nt][dt] = (f32x4){0.f, 0.f, 0.f, 0.f};
            run_branch<2, 2>(clist, nsel, KV + 1024 + g * 128, 3072, VTS + (size_t)(g * 128) * 8192, 8192, qf, m, l, O, t2, mylut, selm + (th * 32 + tok) * 4, 0.f, myimp, kl, vl, kl1, vl1, tid, lane);
#pragma unroll
            for (int nt = 0; nt < 2; ++nt) {
                const float sc = l[nt] > 0.f ? GATES[(size_t)t2[nt] * 48 + g * 12 + r * 3 + 1] / l[nt] : 0.f;
#pragma unroll
                for (int dt = 0; dt < 8; ++dt) {
                    bf16_t* op = Oo + (size_t)t2[nt] * 2048 + h * 128 + dt * 16 + q * 4;
                    const u32x2 w = *(const u32x2*)op;
                    f32x4 v = O[nt][dt] * sc;
                    v[0] += __uint_as_float(w.x << 16); v[1] += __uint_as_float(w.x & 0xffff0000u); v[2] += __uint_as_float(w.y << 16); v[3] += __uint_as_float(w.y & 0xffff0000u);
                    store_bf4(op, v);
                }
                __builtin_amdgcn_sched_barrier(0);
            }
            const int lo = (tt * 64 - 511 > 0 ? tt * 64 - 511 : 0) >> 6, hi = smax;
            if (tid <= hi - lo) clist[tid] = lo + tid;
            __syncthreads();
            m[0] = -1e30f; m[1] = -1e30f; l[0] = 0.f; l[1] = 0.f;
#pragma unroll
            for (int nt = 0; nt < 2; ++nt)
#pragma unroll
                for (int dt = 0; dt < 8; ++dt) O[nt][dt] = (f32x4){0.f, 0.f, 0.f, 0.f};
            run_branch<3, 2>(clist, hi - lo + 1, KV + 2048 + g * 128, 3072, VTW + (size_t)(g * 128) * 8192, 8192, qf, m, l, O, t2, mylut, nullptr, 0.f, myimp, kl, vl, kl1, vl1, tid, lane);
#pragma unroll
            for (int nt = 0; nt < 2; ++nt) {
                const float sc = l[nt] > 0.f ? GATES[(size_t)t2[nt] * 48 + g * 12 + r * 3 + 2] / l[nt] : 0.f;
#pragma unroll
                for (int dt = 0; dt < 8; ++dt) {
                    bf16_t* op = Oo + (size_t)t2[nt] * 2048 + h * 128 + dt * 16 + q * 4;
                    const u32x2 w = *(const u32x2*)op;
                    f32x4 v = O[nt][dt] * sc;
                    v[0] += __uint_as_float(w.x << 16); v[1] += __uint_as_float(w.x & 0xffff0000u); v[2] += __uint_as_float(w.y << 16); v[3] += __uint_as_float(w.y & 0xffff0000u);
                    store_bf4(op, v);
                }
                __builtin_amdgcn_sched_barrier(0);
            }
        }
    }
}

enum { K_NC = 0, K_MIX, K_GEMM, K_PREP, K_SCAN, K_POST, K_IM2COL, K_ATTN };
#ifndef REP_KIND
#define REP_KIND (-1)
#endif
constexpr int NPH = 37, MAX_JOBS = 44, MAX_CONV = 40;
struct PhaseDesc { int kind, njobs, jfirst, total, K, lda, ldb, nconv, cfirst, sub, pad0, pad1; const void* ptr[10]; };
static_assert(sizeof(PhaseDesc) == 128 && NPH * 128 <= LDS_JOBS - LDS_DESC, "desc table");
static_assert(sizeof(Job) == 64 && MAX_JOBS * 64 <= LDS_CONV - LDS_JOBS, "job table");
static_assert(sizeof(Conv) == 32 && MAX_CONV * 32 <= LDS_WORK - LDS_CONV, "conv table");
struct Builder {
    LAS PhaseDesc* pd; LAS Job* jobs; LAS Conv* cv; int nph, nj, nc;
    __device__ __forceinline__ LAS PhaseDesc* phase(int kind) {
        __builtin_amdgcn_sched_barrier(0);
        LAS PhaseDesc* d = pd + nph; ++nph;
        d->kind = kind; d->njobs = 0; d->jfirst = nj; d->total = 0; d->K = D; d->lda = D; d->ldb = D; d->nconv = 0; d->cfirst = nc; d->sub = 0; d->pad0 = (kind == K_PREP) ? 0 : 1; d->pad1 = 0;
#pragma unroll
        for (int i = 0; i < 10; ++i) d->ptr[i] = nullptr;
        return d;
    }
    __device__ __forceinline__ void job(LAS PhaseDesc* d, const void* A, const void* Bt, void* out, const void* aux, const void* aux2, int nM, int nN, int ldc, int mode) {
        __builtin_amdgcn_sched_barrier(0);
        LAS Job* j = jobs + nj; ++nj;
        j->A = (const bf16_t*)A; j->Bt = (const bf16_t*)Bt; j->out = out; j->aux = (const float*)aux; j->aux2 = (const float*)aux2;
        j->nM = nM; j->nN = nN; j->ldc = ldc; j->mode = mode; j->ustart = d->total; j->pad0 = 0;
        d->total = d->total + nM * nN; d->njobs = d->njobs + 1; if (mode == EP_RESID || mode == EP_VMIX) d->pad0 = 0;
    }
    __device__ __forceinline__ void conv(LAS PhaseDesc* d, const float* src, int K, int N, void* dst, int Kp, int Np) {
        __builtin_amdgcn_sched_barrier(0);
        LAS Conv* c = cv + nc; ++nc; c->src = src; c->dst = (bf16_t*)dst; c->K = K; c->N = N; c->Kp = Kp; c->Np = Np; d->nconv = d->nconv + 1;
    }
};

__device__ __forceinline__ const float* vlaunder(const float* x) { asm volatile("" : "+v"(x)); return x; }
#define PIN(i) vlaunder(p.in[i])
#define H ((float*)(ws + OFF_H))
#define X6 ((bf16_t*)(ws + OFF_X6))
#define Rb ((float*)(ws + OFF_R))
#define Wb ((float*)(ws + OFF_W))
#define Kb ((float*)(ws + OFF_K))
#define Vb ((float*)(ws + OFF_V))
#define VFb ((float*)(ws + OFF_VF))
#define NAb ((float*)(ws + OFF_NA))
#define AAb ((float*)(ws + OFF_AA))
#define BONb ((float*)(ws + OFF_BON))
#define Yb ((float*)(ws + OFF_Y))
#define Gb ((float*)(ws + OFF_G))
#define TW ((bf16_t*)(ws + OFF_TW))
#define TA ((bf16_t*)(ws + OFF_TA))
#define TV ((bf16_t*)(ws + OFF_TV))
#define TG ((bf16_t*)(ws + OFF_TG))
#define Zb ((bf16_t*)(ws + OFF_Z))
#define UPT ((bf16_t*)(ws + OFF_MLPW))
#define DNT ((bf16_t*)(ws + OFF_MLPW + 32 * MiB))
#define KVN ((bf16_t*)(ws + OFF_KVN))
#define HN ((bf16_t*)(ws + OFF_HN))
#define KV ((bf16_t*)(ws + OFF_KV))
#define VTS ((bf16_t*)(ws + OFF_VTS))
#define VTW ((bf16_t*)(ws + OFF_VTW))
#define Qb ((bf16_t*)(ws + OFF_Q))
#define GATES ((float*)(ws + OFF_GATES))
#define ACMP ((bf16_t*)(ws + OFF_ACMP))
#define HID ((bf16_t*)(ws + OFF_HID))
#define KC ((bf16_t*)(ws + OFF_KC))
#define VCT ((bf16_t*)(ws + OFF_VCT))
#define Ob ((bf16_t*)(ws + OFF_O))
#define WKV ((bf16_t*)(ws + OFF_WKV))
#define C1 ((float*)(ws + OFF_C1))
#define C1P ((float*)(ws + OFF_C1P))
__device__ __forceinline__ void build_program(const Params& p, LAS unsigned char* lds0) {
    Builder b; b.pd = (LAS PhaseDesc*)(lds0 + LDS_DESC); b.jobs = (LAS Job*)(lds0 + LDS_JOBS); b.cv = (LAS Conv*)(lds0 + LDS_CONV); b.nph = 0; b.nj = 0; b.nc = 0;
    unsigned char* ws = p.ws; asm volatile("" : "+v"(ws));
    const size_t XS = (size_t)T * D;
    LAS PhaseDesc* d;
    asm volatile("" : "+v"(ws)); d = b.phase(K_NC); d->sub = 1; d->ptr[0] = H; d->ptr[6] = PIN(0); d->ptr[7] = PIN(25); d->ptr[8] = PIN(26); d->ptr[9] = C1P;
    {
        unsigned char* w2 = ws + OFF_RW;
        b.conv(d, PIN(3), D, D, w2 + RW_WR, D, D);
        b.conv(d, PIN(4), D, D, w2 + RW_WK, D, D);
        b.conv(d, PIN(5), D, D, w2 + RW_WV, D, D);
        b.conv(d, PIN(6), D, D, w2 + RW_WO, D, D);
        b.conv(d, PIN(8), D, 96, w2 + RW_W1, D, 256);
        b.conv(d, PIN(11), D, 128, w2 + RW_A1, D, 256);
        b.conv(d, PIN(16), D, 256, w2 + RW_G1, D, 256);
        b.conv(d, PIN(9), 96, D, w2 + RW_W2, 256, D);
        b.conv(d, PIN(12), 128, D, w2 + RW_A2, 256, D);
        b.conv(d, PIN(17), 256, D, w2 + RW_G2, 256, D);
    }
    auto mlp = [&](int L, bf16_t* XN, bf16_t* U) {
        asm volatile("" : "+v"(ws)); d = b.phase(K_NC); d->ptr[0] = H; d->ptr[1] = PIN(33) + (size_t)L * D; d->ptr[2] = XN;
        bf16_t* up_t = (L == 2) ? (bf16_t*)(ws + OFF_MLPW2) : UPT; bf16_t* dn_t = (L == 2) ? (bf16_t*)(ws + OFF_MLPW2 + 32 * MiB) : DNT;
        if (L == 3) {
            b.conv(d, PIN(34) + (size_t)L * D * DFF, D, DFF, UPT, D, DFF);
            b.conv(d, PIN(35) + (size_t)L * DFF * D, DFF, D, DNT, DFF, D);
        }
        asm volatile("" : "+v"(ws)); d = b.phase(K_GEMM); b.job(d, XN, up_t, U, nullptr, nullptr, 32, 32, DFF, EP_RELU2);
        asm volatile("" : "+v"(ws)); d = b.phase(K_GEMM); d->K = DFF; d->lda = DFF; d->ldb = DFF; b.job(d, U, dn_t, H, nullptr, nullptr, 32, 8, D, EP_RESID);
    };
#pragma unroll
    for (int i = 0; i < 2; ++i) {
        unsigned char* wb = ws + OFF_RW + i * RW_STRIDE;
        float* Vcur = (i == 0) ? VFb : Vb;
        asm volatile("" : "+v"(ws)); d = b.phase(K_MIX); d->ptr[0] = H; d->ptr[1] = PIN(1) + (size_t)i * D; d->ptr[2] = PIN(2) + (size_t)i * 6 * D; d->ptr[3] = X6;
        asm volatile("" : "+v"(ws)); d = b.phase(K_GEMM);
        b.job(d, X6 + 0 * XS, wb + RW_WR, Rb, nullptr, nullptr, 32, 8, D, EP_F32);
        b.job(d, X6 + 2 * XS, wb + RW_WK, Kb, nullptr, nullptr, 32, 8, D, EP_F32);
        b.job(d, X6 + 3 * XS, wb + RW_WV, Vcur, nullptr, nullptr, 32, 8, D, EP_F32);
        b.job(d, X6 + 1 * XS, wb + RW_W1, TW, nullptr, nullptr, 32, 1, 256, EP_TANH);
        b.job(d, X6 + 4 * XS, wb + RW_A1, TA, nullptr, nullptr, 32, 1, 256, EP_BF16);
        b.job(d, X6 + 5 * XS, wb + RW_G1, TG, nullptr, nullptr, 32, 1, 256, EP_SIGM);
        if (i == 1) b.job(d, X6 + 3 * XS, wb + RW_V1, TV, nullptr, nullptr, 32, 1, 256, EP_BF16);
        asm volatile("" : "+v"(ws)); d = b.phase(K_GEMM); d->K = 256; d->lda = 256; d->ldb = 256;
        b.job(d, TW, wb + RW_W2, Wb, PIN(7) + (size_t)i * D, nullptr, 32, 8, D, EP_DECAY);
        b.job(d, TA, wb + RW_A2, AAb, PIN(10) + (size_t)i * D, nullptr, 32, 8, D, EP_SIGB);
        b.job(d, TG, wb + RW_G2, Gb, nullptr, nullptr, 32, 8, D, EP_F32);
        if (i == 1) b.job(d, TV, wb + RW_V2, Vb, PIN(13), VFb, 32, 8, D, EP_VMIX);
        asm volatile("" : "+v"(ws)); d = b.phase(K_SCAN); d->ptr[0] = Rb; d->ptr[1] = Wb; d->ptr[2] = Kb; d->ptr[3] = Vcur; d->ptr[4] = AAb; d->ptr[5] = PIN(18) + (size_t)i * D; d->ptr[6] = Yb;
        d->ptr[7] = PIN(19) + (size_t)i * D; d->ptr[8] = PIN(20) + (size_t)i * D; d->ptr[9] = BONb;
        b.conv(d, PIN(34) + (size_t)i * D * DFF, D, DFF, UPT, D, DFF);
        b.conv(d, PIN(35) + (size_t)i * DFF * D, DFF, D, DNT, DFF, D);
        if (i == 0) {
            {
                unsigned char* w2 = ws + OFF_RW + RW_STRIDE;
                b.conv(d, PIN(3) + (size_t)D * D, D, D, w2 + RW_WR, D, D);
                b.conv(d, PIN(4) + (size_t)D * D, D, D, w2 + RW_WK, D, D);
                b.conv(d, PIN(5) + (size_t)D * D, D, D, w2 + RW_WV, D, D);
                b.conv(d, PIN(6) + (size_t)D * D, D, D, w2 + RW_WO, D, D);
                b.conv(d, PIN(8) + (size_t)D * 96, D, 96, w2 + RW_W1, D, 256);
                b.conv(d, PIN(11) + (size_t)D * 128, D, 128, w2 + RW_A1, D, 256);
                b.conv(d, PIN(16) + (size_t)D * 256, D, 256, w2 + RW_G1, D, 256);
                b.conv(d, PIN(9) + (size_t)96 * D, 96, D, w2 + RW_W2, 256, D);
                b.conv(d, PIN(12) + (size_t)128 * D, 128, D, w2 + RW_A2, 256, D);
                b.conv(d, PIN(17) + (size_t)256 * D, 256, D, w2 + RW_G2, 256, D);
                b.conv(d, PIN(14), D, 64, w2 + RW_V1, D, 256);
                b.conv(d, PIN(15), 64, D, w2 + RW_V2, 256, D);
            }
            b.conv(d, PIN(24), D, 3072, ws + OFF_WKV, D, 3072);
#pragma unroll
            for (int q = 0; q < 2; ++q) {
                b.conv(d, PIN(26) + (size_t)q * 4096 * 128, 4096, 128, ws + OFF_CW1 + q * 2 * MiB, 4096, 256);
                b.conv(d, PIN(28) + (size_t)q * 128 * 128, 128, 128, ws + OFF_CW2 + q * 131072, 256, 256);
                b.conv(d, PIN(30) + (size_t)q * D * 2096, D, 2096, ws + OFF_WQ + q * WQ_STRIDE, D, 2304);
                b.conv(d, PIN(31) + (size_t)q * D * D, D, D, ws + OFF_NWO + q * 8 * MiB, D, D);
            }
        } else {
            b.conv(d, PIN(34) + (size_t)2 * D * DFF, D, DFF, ws + OFF_MLPW2, D, DFF);
            b.conv(d, PIN(35) + (size_t)2 * DFF * D, DFF, D, ws + OFF_MLPW2 + 32 * MiB, DFF, D);
        }
        asm volatile("" : "+v"(ws)); d = b.phase(K_POST); d->ptr[0] = Yb; d->ptr[1] = BONb; d->ptr[2] = Vcur; d->ptr[3] = Gb; d->ptr[4] = PIN(21) + (size_t)i * D; d->ptr[5] = PIN(22) + (size_t)i * D; d->ptr[6] = Zb;
        asm volatile("" : "+v"(ws)); d = b.phase(K_GEMM); b.job(d, Zb, wb + RW_WO, H, nullptr, nullptr, 32, 8, D, EP_RESID);
        mlp(i, (bf16_t*)(ws + OFF_XN), (bf16_t*)(ws + OFF_U));
    }
#pragma unroll
    for (int j = 0; j < 2; ++j) {
        asm volatile("" : "+v"(ws)); d = b.phase(K_NC); d->ptr[0] = H;
        if (j == 0) { d->ptr[1] = PIN(23); d->ptr[2] = KVN; d->ptr[3] = PIN(29); d->ptr[4] = HN; }
        else { d->ptr[1] = PIN(29) + D; d->ptr[2] = HN; }
        asm volatile("" : "+v"(ws)); d = b.phase(K_GEMM);
        if (j == 0) {
            b.job(d, KVN, WKV, KV, nullptr, nullptr, 32, 6, 3072, EP_BF16);
            b.job(d, KVN, WKV + (size_t)2048 * D, KV + 2048, nullptr, nullptr, 32, 2, 3072, EP_BF16);
            b.job(d, WKV + (size_t)1536 * D, KVN, VTS, nullptr, nullptr, 2, 32, T, EP_BF16);
            b.job(d, WKV + (size_t)2560 * D, KVN, VTW, nullptr, nullptr, 2, 32, T, EP_BF16);
        }
        b.job(d, HN, ws + OFF_WQ + (size_t)j * WQ_STRIDE, Qb, GATES, nullptr, 32, 9, 2048, EP_Q);
        if (j == 0) {
            asm volatile("" : "+v"(ws)); d = b.phase(K_IM2COL); d->ptr[0] = KV; d->ptr[1] = ACMP; d->ptr[2] = C1P; d->ptr[3] = PIN(27); d->ptr[4] = C1;
            asm volatile("" : "+v"(ws)); d = b.phase(K_GEMM); d->K = 4096; d->lda = 4096; d->ldb = 4096;
            b.job(d, ACMP, ws + OFF_CW1, HID, C1, nullptr, 8, 1, 256, EP_GELU);
            b.job(d, ACMP + (size_t)2048 * 4096, ws + OFF_CW1 + 2 * MiB, HID + (size_t)2048 * 256, C1 + 256, nullptr, 8, 1, 256, EP_GELU);
            asm volatile("" : "+v"(ws)); d = b.phase(K_GEMM); d->K = 256; d->lda = 256; d->ldb = 256;
            b.job(d, HID, ws + OFF_CW2, KC, nullptr, nullptr, 8, 1, 256, EP_BF16);
            b.job(d, ws + OFF_CW2 + 131072, HID + (size_t)2048 * 256, VCT, nullptr, nullptr, 1, 8, 2048, EP_BF16);
        }
        asm volatile("" : "+v"(ws)); d = b.phase(K_ATTN); d->ptr[0] = Qb; d->ptr[1] = GATES; d->ptr[2] = KV; d->ptr[3] = VTS; d->ptr[4] = VTW; d->ptr[5] = KC; d->ptr[6] = VCT; d->ptr[7] = PIN(32); d->ptr[8] = Ob;
        asm volatile("" : "+v"(ws)); d = b.phase(K_GEMM); b.job(d, Ob, ws + OFF_NWO + (size_t)j * 8 * MiB, H, nullptr, nullptr, 32, 8, D, EP_RESID);
        mlp(2 + j, (bf16_t*)(ws + OFF_XN2), (bf16_t*)(ws + OFF_U2));
    }
    asm volatile("" : "+v"(ws)); d = b.phase(K_NC); d->ptr[0] = H; d->ptr[1] = PIN(36); { float* po = p.out; asm volatile("" : "+v"(po)); d->ptr[5] = po; }
}

#undef H
#undef X6
#undef Rb
#undef Wb
#undef Kb
#undef Vb
#undef VFb
#undef NAb
#undef AAb
#undef BONb
#undef Yb
#undef Gb
#undef TW
#undef TA
#undef TV
#undef TG
#undef Zb
#undef UPT
#undef DNT
#undef KVN
#undef HN
#undef KV
#undef VTS
#undef VTW
#undef Qb
#undef GATES
#undef ACMP
#undef HID
#undef KC
#undef VCT
#undef Ob
#undef WKV
#undef C1
#undef C1P
#undef PIN
#define XB_TMO      128
#define XB_XCNT(j)  (256  + 64 * (j))
#define XB_XSUB(j)  (1280 + 64 * (j))
#define XB_XGEN(j)  (2304 + 64 * (j))
#define XB_TOP      3328
#define XB_TOPGEN   3392
#define XCD_BAR_WORDS 3456
#define XB_SPIN_CAP (1u << 18)
constexpr size_t OFF_BAR = OFF_C1 + 16384;
__device__ __forceinline__ unsigned xb_ld(unsigned* p)              { return __hip_atomic_load(p, __ATOMIC_RELAXED, __HIP_MEMORY_SCOPE_AGENT); }
__device__ __forceinline__ unsigned xb_add(unsigned* p, unsigned v) { return __hip_atomic_fetch_add(p, v, __ATOMIC_RELAXED, __HIP_MEMORY_SCOPE_AGENT); }
__device__ __forceinline__ unsigned xb_xcc_id() { return (unsigned)__builtin_amdgcn_s_getreg((3 << 11) | 20) & 0xFu; }
#define XB_SPIN(cond, bar) do { unsigned _sp = 0; while (cond) { __builtin_amdgcn_s_sleep(1); \
    if ((++_sp & 255u) == 0u) { if (xb_ld(&(bar)[XB_TMO])) break; if (_sp > XB_SPIN_CAP) { atomicAdd(&(bar)[XB_TMO], 1u); break; } } } } while (0)
__device__ __forceinline__ void xcd_barrier_complete(unsigned* bar, unsigned x, unsigned& nloc, unsigned& nx) {
    const unsigned G = gridDim.x * gridDim.y * gridDim.z;
    unsigned sum, cnt, mine, sp = 0u;
    for (;;) {
        sum = 0u; cnt = 0u; mine = 0u;
#pragma unroll
        for (unsigned j = 0; j < 16; ++j) { const unsigned c = xb_ld(&bar[XB_XCNT(j)]); sum += c; cnt += (c > 0u) ? 1u : 0u; mine = (j == x) ? c : mine; }
        if (sum == G) break;
        __builtin_amdgcn_s_sleep(1);
        if ((++sp & 255u) == 0u) { if (xb_ld(&bar[XB_TMO])) break; if (sp > XB_SPIN_CAP) { atomicAdd(&bar[XB_TMO], 1u); break; } }
    }
    nloc = mine > 0u ? mine : 1u; nx = cnt > 0u ? cnt : 1u;
}
__device__ __forceinline__ void xcd_barrier(unsigned* bar, volatile LAS unsigned* st) {
    asm volatile("s_waitcnt vmcnt(0)" ::: "memory");
    __syncthreads();
    if (threadIdx.x == 0) {
        const unsigned x = xb_xcc_id();
        __builtin_amdgcn_s_waitcnt(0);
        unsigned nloc = st[0], nx = st[1];
        if (nloc == 0u) { xcd_barrier_complete(bar, x, nloc, nx); st[0] = nloc; st[1] = nx; }
        const unsigned old = xb_add(&bar[XB_XSUB(x)], 1u);
        const unsigned gen = old / nloc;
        if (old + 1u == (gen + 1u) * nloc) {
            __builtin_amdgcn_fence(__ATOMIC_RELEASE, "agent");
            asm volatile("s_waitcnt vmcnt(0)" ::: "memory");
            const unsigned og = xb_add(&bar[XB_TOP], 1u);
            const unsigned tg = og / nx;
            if (og + 1u == (tg + 1u) * nx) xb_add(&bar[XB_TOPGEN], 1u);
            else XB_SPIN(xb_ld(&bar[XB_TOPGEN]) == tg, bar);
            __builtin_amdgcn_fence(__ATOMIC_ACQUIRE, "agent");
            xb_add(&bar[XB_XGEN(x)], 1u);
            asm volatile("s_waitcnt vmcnt(0)" ::: "memory");
        } else {
            XB_SPIN(xb_ld(&bar[XB_XGEN(x)]) == gen, bar);
            __builtin_amdgcn_fence(__ATOMIC_ACQUIRE, "agent");
            asm volatile("s_waitcnt vmcnt(0)" ::: "memory");
        }
    }
    __syncthreads();
}

__global__ void __launch_bounds__(512, 2) mega(Params p) {
    extern __shared__ __attribute__((aligned(16))) unsigned char smem[];
    LAS unsigned char* lds0 = (LAS unsigned char*)smem;
    cg::grid_group grid = cg::this_grid();
    volatile LAS unsigned* bar_st = (volatile LAS unsigned*)(lds0 + LDS_DESC + NPH * 128 + 96);
    if (threadIdx.x == 0) {
        bar_st[0] = 0u; bar_st[1] = 0u;
        (void)xb_add(&((unsigned*)(p.ws + OFF_BAR))[XB_XCNT(xb_xcc_id())], 1u);
        build_program(p, lds0);
        LAS unsigned char* ord = lds0 + LDS_DESC + NPH * 128; int n = 0;
        for (int i = 0; i < NPH; ++i) {
            const LAS PhaseDesc* dd = (const LAS PhaseDesc*)(lds0 + LDS_DESC) + i;
            ord[n++] = (unsigned char)i;
            if (dd->kind == REP_KIND && dd->pad0) ord[n++] = (unsigned char)i;
        }
        ord[127] = (unsigned char)n;
    }
    __syncthreads();
    const int nord = __builtin_amdgcn_readfirstlane((int)lds0[LDS_DESC + NPH * 128 + 127]);
    for (int oi = 0; oi < nord; ++oi) {
        const int ph = __builtin_amdgcn_readfirstlane((int)lds0[LDS_DESC + NPH * 128 + oi]);
        const int tid = ltid(), nb = gridDim.x, bid = blockIdx.x;
        LAS unsigned char* lds = lds0 + LDS_WORK;
        const LAS PhaseDesc* d = (const LAS PhaseDesc*)(lds0 + LDS_DESC) + ph;
        const int kind = __builtin_amdgcn_readfirstlane(d->kind);
        if (kind == K_NC) {
            const float* Hh = uptr((const float*)d->ptr[0]);
            if (d->sub == 1) {
                const f32x4* xs = (const f32x4*)d->ptr[6];
                for (size_t i = (size_t)bid * 512 + tid; i < (size_t)T * D / 4; i += (size_t)nb * 512) ((f32x4*)Hh)[i] = xs[i];
                if (bid < 16) {
                    const int q = bid >> 3, ks = (bid & 7) * 4 + (tid >> 7), n = tid & 127;
                    const float* pe = (const float*)d->ptr[7] + (size_t)q * 4096; const float* w1 = (const float*)d->ptr[8] + (size_t)q * 4096 * 128;
                    float s = 0.f;
                    for (int k = ks * 128; k < ks * 128 + 128; ++k) s += pe[k] * w1[(size_t)k * 128 + n];
                    ((float*)d->ptr[9])[(q * 32 + ks) * 128 + n] = s;
                }
            }
            const float* g1 = uptr((const float*)d->ptr[1]);
            if (g1) phase_norm(Hh, g1, uptr((bf16_t*)d->ptr[2]), uptr((const float*)d->ptr[3]), uptr((bf16_t*)d->ptr[4]), uptr((float*)d->ptr[5]));
            __syncthreads();
            int off = 0;
            const int nconv = __builtin_amdgcn_readfirstlane(d->nconv), cfirst = __builtin_amdgcn_readfirstlane(d->cfirst);
            for (int c = 0; c < nconv; ++c) {
                const LAS Conv* cc = (const LAS Conv*)(lds0 + LDS_CONV) + cfirst + c;
                convT(uptr(cc->src), __builtin_amdgcn_readfirstlane(cc->K), __builtin_amdgcn_readfirstlane(cc->N), uptr(cc->dst), __builtin_amdgcn_readfirstlane(cc->Kp),
                      __builtin_amdgcn_readfirstlane(cc->Np), (LAS float*)lds, off);
            }
        } else if (kind == K_MIX) {
            phase_mix(uptr((const float*)d->ptr[0]), uptr((const float*)d->ptr[1]), uptr((const float*)d->ptr[2]), uptr((bf16_t*)d->ptr[3]));
        } else if (kind == K_GEMM) {
            gemm_phase(lds, (const LAS Job*)(lds0 + LDS_JOBS) + __builtin_amdgcn_readfirstlane(d->jfirst), __builtin_amdgcn_readfirstlane(d->njobs), __builtin_amdgcn_readfirstlane(d->total),
                       __builtin_amdgcn_readfirstlane(d->K), __builtin_amdgcn_readfirstlane(d->lda), __builtin_amdgcn_readfirstlane(d->ldb));
        } else if (kind == K_PREP) {
            phase_prep(uptr((const float*)d->ptr[0]), uptr((float*)d->ptr[1]), uptr((float*)d->ptr[2]), uptr((float*)d->ptr[3]), uptr((float*)d->ptr[4]),
                       uptr((const float*)d->ptr[5]), uptr((const float*)d->ptr[6]), uptr((const float*)d->ptr[7]));
        } else if (kind == K_SCAN) {
            phase_scan(uptr((const float*)d->ptr[0]), uptr((const float*)d->ptr[1]), uptr((const float*)d->ptr[2]), uptr((const float*)d->ptr[3]), uptr((const float*)d->ptr[4]),
                       uptr((const float*)d->ptr[5]), uptr((float*)d->ptr[6]), uptr((const float*)d->ptr[7]), uptr((const float*)d->ptr[8]), uptr((float*)d->ptr[9]), lds,
                       (const LAS Conv*)(lds0 + LDS_CONV) + __builtin_amdgcn_readfirstlane(d->cfirst), __builtin_amdgcn_readfirstlane(d->nconv));
        } else if (kind == K_POST) {
            phase_post(uptr((const float*)d->ptr[0]), uptr((const float*)d->ptr[1]), uptr((const float*)d->ptr[2]), uptr((const float*)d->ptr[3]), uptr((const float*)d->ptr[4]),
                       uptr((const float*)d->ptr[5]), uptr((bf16_t*)d->ptr[6]));
        } else if (kind == K_IM2COL) {
            const bf16_t* KV = uptr((const bf16_t*)d->ptr[0]); bf16_t* ACMP = uptr((bf16_t*)d->ptr[1]);
            for (size_t i = (size_t)bid * 512 + tid; i < (size_t)2 * 2048 * 512; i += (size_t)nb * 512) {
                const int k8 = (int)(i & 511), row = (int)((i >> 9) & 2047), q = (int)(i >> 20);
                const int c = row & 511, g = row >> 9, k = k8 * 8, l = k >> 7, dd = k & 127;
                u32x4 v = {0u, 0u, 0u, 0u};
                if (c < 511) v = *(const u32x4*)(KV + (size_t)(16 * c + l) * 3072 + q * 512 + g * 128 + dd);
                *(u32x4*)(ACMP + ((size_t)q * 2048 + row) * 4096 + k) = v;
            }
            if (bid == 0) {
                const int q = tid >> 8, n = tid & 255;
                float s = 0.f;
                if (n < 128) { s = ((const float*)d->ptr[3])[q * 128 + n]; for (int ks = 0; ks < 32; ++ks) s += ((const float*)d->ptr[2])[(q * 32 + ks) * 128 + n]; }
                ((float*)d->ptr[4])[q * 256 + n] = s;
            }
        } else {
            phase_attn(uptr((const bf16_t*)d->ptr[0]), uptr((const float*)d->ptr[1]), uptr((const bf16_t*)d->ptr[2]), uptr((const bf16_t*)d->ptr[3]), uptr((const bf16_t*)d->ptr[4]),
                       uptr((const bf16_t*)d->ptr[5]), uptr((const bf16_t*)d->ptr[6]), uptr((const float*)d->ptr[7]), uptr((bf16_t*)d->ptr[8]), lds);
        }
        if (oi == 0) grid.sync();
        else xcd_barrier((unsigned*)(p.ws + OFF_BAR), bar_st);
    }
}

extern "C" void kernel_launch(void* const* d_in, const int* in_sizes, int n_in, void* d_out, int out_size, void* d_ws, size_t ws_size, hipStream_t stream) {
    static int grid_blocks = 0;
    if (grid_blocks == 0) {
        if (n_in != 37 || ws_size < WS_NEED) { fprintf(stderr, "kernel_launch: unexpected n_in %d or ws_size %zu (need %zu)\n", n_in, ws_size, (size_t)WS_NEED); grid_blocks = -1; return; }
        int dev = 0, cus = 0, per_cu = 0;
        (void)hipGetDevice(&dev);
        (void)hipDeviceGetAttribute(&cus, hipDeviceAttributeMultiprocessorCount, dev);
        (void)hipFuncSetAttribute((const void*)mega, hipFuncAttributeMaxDynamicSharedMemorySize, LDS_BYTES);
        (void)hipOccupancyMaxActiveBlocksPerMultiprocessor(&per_cu, (const void*)mega, 512, LDS_BYTES);
        if (per_cu < 1) { fprintf(stderr, "kernel_launch: occupancy query returned %d\n", per_cu); per_cu = 1; }
        grid_blocks = cus * per_cu;
    }
    if (grid_blocks < 0) return;
    Params p{};
    for (int i = 0; i < 37; ++i) p.in[i] = (const float*)d_in[i];
    p.out = (float*)d_out; p.ws = (unsigned char*)d_ws;
    (void)hipMemsetAsync((unsigned char*)d_ws + OFF_BAR, 0, XCD_BAR_WORDS * sizeof(unsigned), stream);
    void* args[] = {&p};
    hipError_t e = hipLaunchCooperativeKernel((const void*)mega, dim3(grid_blocks), dim3(512), args, LDS_BYTES, stream);
    if (e != hipSuccess) fprintf(stderr, "cooperative launch failed: %s (grid %d)\n", hipGetErrorString(e), grid_blocks);
}
```

```cpp
#include <hip/hip_runtime.h>
#include <hip/hip_cooperative_groups.h>
#include <cstdio>
namespace cg = cooperative_groups;

#define LAS __attribute__((address_space(3)))
#define GAS __attribute__((address_space(1)))
typedef unsigned short bf16_t;
typedef short bf16x8 __attribute__((ext_vector_type(8)));
typedef short bf16x4 __attribute__((ext_vector_type(4)));
typedef float f32x4 __attribute__((ext_vector_type(4)));
typedef float f32x2v __attribute__((ext_vector_type(2)));
typedef unsigned u32x2 __attribute__((ext_vector_type(2)));
typedef unsigned u32x4 __attribute__((ext_vector_type(4)));

constexpr int T = 8192, D = 2048, DFF = 8192;
constexpr size_t MiB = 1ull << 20;
constexpr size_t OFF_RW = 0, RW_STRIDE = 40 * MiB;
constexpr size_t RW_WR = 0, RW_WK = 8 * MiB, RW_WV = 16 * MiB, RW_WO = 24 * MiB, RW_W1 = 32 * MiB, RW_A1 = 33 * MiB, RW_V1 = 34 * MiB, RW_G1 = 35 * MiB,
                 RW_W2 = 36 * MiB, RW_A2 = 37 * MiB, RW_V2 = 38 * MiB, RW_G2 = 39 * MiB;
constexpr size_t OFF_WKV = 80 * MiB, OFF_CW1 = 92 * MiB, OFF_CW2 = 96 * MiB, OFF_WQ = 97 * MiB, WQ_STRIDE = 9 * MiB, OFF_NWO = 115 * MiB,
                 OFF_C1 = 131 * MiB, OFF_C1P = 131 * MiB + 65536, OFF_MLPW = 132 * MiB, OFF_H = 196 * MiB, OFF_S = 260 * MiB;
constexpr size_t OFF_X6 = OFF_S, OFF_R = OFF_S + 192 * MiB, OFF_W = OFF_R + 64 * MiB, OFF_K = OFF_W + 64 * MiB, OFF_V = OFF_K + 64 * MiB, OFF_VF = OFF_V + 64 * MiB,
                 OFF_NA = OFF_VF + 64 * MiB, OFF_AA = OFF_NA + 64 * MiB, OFF_TW = OFF_AA + 64 * MiB, OFF_TA = OFF_TW + 4 * MiB, OFF_TV = OFF_TA + 4 * MiB, OFF_TG = OFF_TV + 4 * MiB,
                 OFF_BON = OFF_TG + 4 * MiB, OFF_RW_END = OFF_BON + 1 * MiB;
constexpr size_t OFF_U = OFF_R, OFF_Y = OFF_X6 + 64 * MiB, OFF_G = OFF_X6 + 128 * MiB, OFF_Z = OFF_X6 + 32 * MiB, OFF_XN = OFF_X6;
constexpr size_t OFF_KVN = OFF_S, OFF_HN = OFF_S + 32 * MiB, OFF_KV = OFF_S + 64 * MiB, OFF_VTS = OFF_S + 112 * MiB, OFF_VTW = OFF_S + 120 * MiB, OFF_Q = OFF_S + 128 * MiB,
                 OFF_GATES = OFF_S + 160 * MiB, OFF_ACMP = OFF_S + 162 * MiB, OFF_HID = OFF_S + 194 * MiB, OFF_KC = OFF_S + 196 * MiB, OFF_VCT = OFF_S + 197 * MiB,
                 OFF_O = OFF_S + 198 * MiB, OFF_XN2 = OFF_S + 230 * MiB, OFF_U2 = OFF_S + 262 * MiB;
constexpr size_t OFF_MLPW2 = OFF_RW_END, WS_NEED = OFF_MLPW2 + 64 * MiB;
constexpr int LDS_BYTES = 138 * 1024, LDS_DESC = 0, LDS_JOBS = 5120, LDS_CONV = 7936, LDS_WORK = 9216;

struct Params { const float* in[37]; float* out; unsigned char* ws; };

__device__ __forceinline__ int ltid() { int t = threadIdx.x; asm volatile("" : "+v"(t)); return t; }
__device__ __forceinline__ unsigned cvt_pk_bf16(float lo, float hi) { unsigned r; asm volatile("v_cvt_pk_bf16_f32 %0, %1, %2" : "=v"(r) : "v"(lo), "v"(hi)); return r; }
__device__ __forceinline__ void store_bf4(bf16_t* p, f32x4 v) { u32x2 w; w.x = cvt_pk_bf16(v[0], v[1]); w.y = cvt_pk_bf16(v[2], v[3]); *(u32x2*)p = w; }
__device__ __forceinline__ float wave_sum(float v) {
#pragma unroll
    for (int o = 32; o; o >>= 1) v += __shfl_xor(v, o);
    return v;
}
template <int CTRL> __device__ __forceinline__ float dpp_f(float x) { return __int_as_float(__builtin_amdgcn_update_dpp(0, __float_as_int(x), CTRL, 0xF, 0xF, true)); }
__device__ __forceinline__ float red16(float x) { x += dpp_f<0xB1>(x); x += dpp_f<0x4E>(x); x += dpp_f<0x141>(x); x += dpp_f<0x140>(x); return x; }
__device__ __forceinline__ float xmax4(float x) {
    auto a = __builtin_amdgcn_permlane16_swap(__float_as_uint(x), __float_as_uint(x), false, false);
    x = fmaxf(__uint_as_float(a[0]), __uint_as_float(a[1]));
    auto b = __builtin_amdgcn_permlane32_swap(__float_as_uint(x), __float_as_uint(x), false, false);
    return fmaxf(__uint_as_float(b[0]), __uint_as_float(b[1]));
}
__device__ __forceinline__ float xsum4(float x) {
    auto a = __builtin_amdgcn_permlane16_swap(__float_as_uint(x), __float_as_uint(x), false, false);
    x = __uint_as_float(a[0]) + __uint_as_float(a[1]);
    auto b = __builtin_amdgcn_permlane32_swap(__float_as_uint(x), __float_as_uint(x), false, false);
    return __uint_as_float(b[0]) + __uint_as_float(b[1]);
}
__device__ __forceinline__ float sigmoidf_(float x) { return 1.f / (1.f + __expf(-x)); }
__device__ __forceinline__ float tanhf_(float x) { float e = __expf(2.f * x); return 1.f - 2.f / (e + 1.f); }
__device__ __forceinline__ void wave_fence() { __builtin_amdgcn_fence(__ATOMIC_SEQ_CST, "wavefront"); __builtin_amdgcn_wave_barrier(); }

template <class P> __device__ __forceinline__ P uptr(P x) {
    unsigned long long v = (unsigned long long)x;
    const unsigned lo = __builtin_amdgcn_readfirstlane((unsigned)v), hi = __builtin_amdgcn_readfirstlane((unsigned)(v >> 32));
    return (P)(((unsigned long long)hi << 32) | lo);
}

__device__ __forceinline__ void convT(const float* __restrict__ src, int K, int N, bf16_t* __restrict__ dst, int Kp, int Np, LAS float* tile, int& off) {
    const int tid = ltid(), nb = gridDim.x;
    const int tn = Np / 64, ntile = (Kp / 64) * tn;
    int start = ((int)blockIdx.x - (off % nb) + nb) % nb;
    off += ntile;
    const int kl0 = tid >> 4, nl0 = (tid & 15) * 4;
    f32x4 pv[2];
#define CONV_LOAD(ti_) do { const int k0_ = ((ti_) / tn) * 64, n0_ = ((ti_) % tn) * 64; _Pragma("unroll") for (int i = 0; i < 2; ++i) { \
        const int kk_ = k0_ + kl0 + 32 * i, nn_ = n0_ + nl0; pv[i] = (f32x4){0.f, 0.f, 0.f, 0.f}; \
        if (kk_ < K && nn_ < N) pv[i] = *(const GAS f32x4*)(src + (size_t)kk_ * N + nn_); } } while (0)
    if (start < ntile) CONV_LOAD(start);
    for (int ti = start; ti < ntile; ti += nb) {
        const int k0 = (ti / tn) * 64, n0 = (ti % tn) * 64;
        const f32x4 c0 = pv[0], c1 = pv[1];
        if (ti + nb < ntile) CONV_LOAD(ti + nb);
        tile[(nl0 + 0) * 65 + kl0] = c0[0]; tile[(nl0 + 1) * 65 + kl0] = c0[1]; tile[(nl0 + 2) * 65 + kl0] = c0[2]; tile[(nl0 + 3) * 65 + kl0] = c0[3];
        tile[(nl0 + 0) * 65 + kl0 + 32] = c1[0]; tile[(nl0 + 1) * 65 + kl0 + 32] = c1[1]; tile[(nl0 + 2) * 65 + kl0 + 32] = c1[2]; tile[(nl0 + 3) * 65 + kl0 + 32] = c1[3];
        __syncthreads();
        {
            const int nl = tid >> 3, k8 = (tid & 7) * 8;
            const LAS float* tp = tile + nl * 65 + k8;
            u32x4 w; w.x = cvt_pk_bf16(tp[0], tp[1]); w.y = cvt_pk_bf16(tp[2], tp[3]); w.z = cvt_pk_bf16(tp[4], tp[5]); w.w = cvt_pk_bf16(tp[6], tp[7]);
            *(GAS u32x4*)(dst + (size_t)(n0 + nl) * Kp + k0 + k8) = w;
        }
        __syncthreads();
    }
#undef CONV_LOAD
}

__device__ __forceinline__ void phase_mix(const float* __restrict__ H, const float* __restrict__ gn, const float* __restrict__ mu, bf16_t* __restrict__ X6) {
    const int wid = ltid() >> 6, lane = ltid() & 63;
    for (int row = blockIdx.x * 8 + wid; row < T; row += gridDim.x * 8) {
        const float* hp = H + (size_t)row * D;
        f32x4 x[8], xp[8];
        float ss = 0.f, ssp = 0.f;
#pragma unroll
        for (int i = 0; i < 8; ++i) { x[i] = *(const f32x4*)(hp + i * 256 + lane * 4); ss += x[i][0] * x[i][0] + x[i][1] * x[i][1] + x[i][2] * x[i][2] + x[i][3] * x[i][3]; }
        if (row > 0) {
#pragma unroll
            for (int i = 0; i < 8; ++i) { xp[i] = *(const f32x4*)(hp - D + i * 256 + lane * 4); ssp += xp[i][0] * xp[i][0] + xp[i][1] * xp[i][1] + xp[i][2] * xp[i][2] + xp[i][3] * xp[i][3]; }
        } else {
#pragma unroll
            for (int i = 0; i < 8; ++i) xp[i] = (f32x4){0.f, 0.f, 0.f, 0.f};
        }
        ss = wave_sum(ss); ssp = wave_sum(ssp);
        const float rs = rsqrtf(ss * (1.f / D) + 1e-6f), rsp = row > 0 ? rsqrtf(ssp * (1.f / D) + 1e-6f) : 0.f;
#pragma unroll
        for (int i = 0; i < 8; ++i) {
            const int col = i * 256 + lane * 4;
            const f32x4 g4 = *(const f32x4*)(gn + col);
            const f32x4 xn = x[i] * rs * g4, dx = xp[i] * rsp * g4 - xn;
#pragma unroll
            for (int j = 0; j < 6; ++j) {
                const f32x4 m4 = *(const f32x4*)(mu + j * D + col);
                store_bf4(X6 + (size_t)j * T * D + (size_t)row * D + col, xn + dx * m4);
            }
        }
    }
}
__device__ __forceinline__ void phase_norm(const float* __restrict__ H, const float* __restrict__ g1, bf16_t* __restrict__ o1, const float* __restrict__ g2, bf16_t* __restrict__ o2, float* __restrict__ fout) {
    const int wid = ltid() >> 6, lane = ltid() & 63;
    for (int row = blockIdx.x * 8 + wid; row < T; row += gridDim.x * 8) {
        const float* hp = H + (size_t)row * D;
        f32x4 x[8]; float ss = 0.f;
#pragma unroll
        for (int i = 0; i < 8; ++i) { x[i] = *(const f32x4*)(hp + i * 256 + lane * 4); ss += x[i][0] * x[i][0] + x[i][1] * x[i][1] + x[i][2] * x[i][2] + x[i][3] * x[i][3]; }
        ss = wave_sum(ss);
        const float rs = rsqrtf(ss * (1.f / D) + 1e-6f);
#pragma unroll
        for (int i = 0; i < 8; ++i) {
            const int col = i * 256 + lane * 4;
            const f32x4 y = x[i] * rs * *(const f32x4*)(g1 + col);
            if (fout) *(f32x4*)(fout + (size_t)row * D + col) = y;
            else store_bf4(o1 + (size_t)row * D + col, y);
            if (g2) store_bf4(o2 + (size_t)row * D + col, x[i] * rs * *(const f32x4*)(g2 + col));
        }
    }
}
__device__ __forceinline__ void phase_prep(const float* __restrict__ R, float* __restrict__ Kb, float* __restrict__ AA, float* __restrict__ NA, float* __restrict__ BON,
                           const float* __restrict__ k_k, const float* __restrict__ k_a, const float* __restrict__ r_k) {
    const int wid = ltid() >> 6, lane = ltid() & 63;
    for (int row = blockIdx.x * 8 + wid; row < T; row += gridDim.x * 8) {
#pragma unroll 2
        for (int i = 0; i < 8; ++i) {
            const int col = i * 256 + lane * 4; const size_t o = (size_t)row * D + col;
            const f32x4 k = *(const f32x4*)(Kb + o), a = *(const f32x4*)(AA + o), r = *(const f32x4*)(R + o);
            f32x4 kk = k * *(const f32x4*)(k_k + col);
            float ss = red16(kk[0] * kk[0] + kk[1] * kk[1] + kk[2] * kk[2] + kk[3] * kk[3]);
            kk = kk * rsqrtf(fmaxf(ss, 1e-24f));
            const f32x4 kp = k * (1.f + (a - 1.f) * *(const f32x4*)(k_a + col));
            const f32x4 rk = r * kp * *(const f32x4*)(r_k + col);
            const float bon = red16(rk[0] + rk[1] + rk[2] + rk[3]);
            *(f32x4*)(Kb + o) = kp; *(f32x4*)(NA + o) = -kk; *(f32x4*)(AA + o) = kk * a;
            if ((lane & 15) == 0) BON[(size_t)row * 32 + i * 4 + (lane >> 4)] = bon;
        }
    }
}
__device__ __forceinline__ void phase_post(const float* __restrict__ Y, const float* __restrict__ BON, const float* __restrict__ V, const float* __restrict__ G,
                           const float* __restrict__ lw, const float* __restrict__ lb, bf16_t* __restrict__ Z) {
    const int wid = ltid() >> 6, lane = ltid() & 63;
    for (int row = blockIdx.x * 8 + wid; row < T; row += gridDim.x * 8) {
#pragma unroll 2
        for (int i = 0; i < 8; ++i) {
            const int col = i * 256 + lane * 4; const size_t o = (size_t)row * D + col;
            const f32x4 y = *(const f32x4*)(Y + o);
            const float mean = red16(y[0] + y[1] + y[2] + y[3]) * (1.f / 64.f);
            const f32x4 d = y - mean;
            const float var = red16(d[0] * d[0] + d[1] * d[1] + d[2] * d[2] + d[3] * d[3]) * (1.f / 64.f);
            const f32x4 yn = d * rsqrtf(var + 64e-5f) * *(const f32x4*)(lw + col) + *(const f32x4*)(lb + col);
            const float bon = BON[(size_t)row * 32 + i * 4 + (lane >> 4)];
            store_bf4(Z + o, (yn + bon * *(const f32x4*)(V + o)) * *(const f32x4*)(G + o));
        }
    }
}

struct Conv { const float* src; bf16_t* dst; int K, N, Kp, Np; };
__device__ __forceinline__ void conv_worker(const LAS Conv* cv, int nconv, int wg, int nw, LAS unsigned short* tl, int lane) {
    const int l15 = lane & 15, q = lane >> 4;
    int off = 0;
    for (int ci = 0; ci < nconv; ++ci) {
        const float* __restrict__ src = uptr(cv[ci].src); bf16_t* __restrict__ dst = uptr(cv[ci].dst);
        const int K = __builtin_amdgcn_readfirstlane(cv[ci].K), N = __builtin_amdgcn_readfirstlane(cv[ci].N), Kp = __builtin_amdgcn_readfirstlane(cv[ci].Kp), Np = __builtin_amdgcn_readfirstlane(cv[ci].Np);
        const int tn = Np / 64, ntile = (Kp / 32) * tn;
        const int start = (wg - (off % nw) + nw) % nw;
        off += ntile;
        f32x4 pv[8];
#define CW_LOAD(ti_) do { const int k0_ = ((ti_) / tn) * 32, n0_ = ((ti_) % tn) * 64; _Pragma("unroll") for (int i = 0; i < 8; ++i) { \
            const int kk_ = k0_ + q + 4 * i, nn_ = n0_ + l15 * 4; pv[i] = (f32x4){0.f, 0.f, 0.f, 0.f}; \
            if (kk_ < K && nn_ < N) pv[i] = *(const GAS f32x4*)(src + (size_t)kk_ * N + nn_); } } while (0)
        if (start < ntile) CW_LOAD(start);
        for (int ti = start; ti < ntile; ti += nw) {
            const int k0 = (ti / tn) * 32, n0 = (ti % tn) * 64;
            f32x4 c[8];
#pragma unroll
            for (int i = 0; i < 8; ++i) c[i] = pv[i];
            if (ti + nw < ntile) CW_LOAD(ti + nw);
#pragma unroll
            for (int i = 0; i < 8; ++i) {
                const unsigned p01 = cvt_pk_bf16(c[i][0], c[i][1]), p23 = cvt_pk_bf16(c[i][2], c[i][3]);
                const int kl = q + 4 * i;
                tl[(l15 * 4 + 0) * 34 + kl] = (unsigned short)(p01 & 0xffffu); tl[(l15 * 4 + 1) * 34 + kl] = (unsigned short)(p01 >> 16);
                tl[(l15 * 4 + 2) * 34 + kl] = (unsigned short)(p23 & 0xffffu); tl[(l15 * 4 + 3) * 34 + kl] = (unsigned short)(p23 >> 16);
            }
            wave_fence();
            const LAS unsigned* rp = (const LAS unsigned*)(tl + lane * 34);
#pragma unroll
            for (int j = 0; j < 4; ++j) { u32x4 w; w.x = rp[4 * j + 0]; w.y = rp[4 * j + 1]; w.z = rp[4 * j + 2]; w.w = rp[4 * j + 3]; *(GAS u32x4*)(dst + (size_t)(n0 + lane) * Kp + k0 + 8 * j) = w; }
            wave_fence();
        }
#undef CW_LOAD
    }
}

__device__ __forceinline__ void phase_scan(const float* __restrict__ R, const float* __restrict__ W, const float* __restrict__ Kb, const float* __restrict__ V,
                           const float* __restrict__ AA, const float* __restrict__ k_k, float* __restrict__ Y, const float* __restrict__ k_a, const float* __restrict__ r_k,
                           float* __restrict__ BON, LAS unsigned char* lds, const LAS Conv* cv, int nconv) {
    const int wid = ltid() >> 6, lane = ltid() & 63, nb = gridDim.x;
    constexpr int CH = 16, BUF_F = CH * 320 + 64;
    constexpr int NBUF = 3;
    volatile LAS int* flags = (volatile LAS int*)(lds + 2 * (NBUF * BUF_F) * 4);
    if (ltid() < 16) flags[ltid()] = 0;
    __syncthreads();
    if (wid >= 6) {
        if (wid == 6) conv_worker(cv, nconv, (int)blockIdx.x, nb, (LAS unsigned short*)(lds + 2 * (NBUF * BUF_F) * 4 + 64), lane);
        return;
    }
    if (wid >= 4) return;
    const int p = wid & 1;
    LAS float* wbase = (LAS float*)lds + p * (NBUF * BUF_F);
    volatile LAS int* ready = flags + p * 8; volatile LAS int* done = flags + p * 8 + 4;
    const int rl = lane >> 4, cl = lane & 15;
    for (int u = (int)blockIdx.x + nb * p; u < 512; u += nb * 2) {
        int head, rowgrp;
        if (nb == 256) { const int xcd = blockIdx.x & 7, slot = (blockIdx.x >> 3) + 32 * p; head = xcd * 4 + (slot >> 4); rowgrp = slot & 15; }
        else { head = u >> 4; rowgrp = u & 15; }
        const int cbase = head * 64, rowbase = rowgrp * 4;
        const int ubase = ((u - (int)blockIdx.x - nb * p) / (nb * 2)) * ((T / CH + NBUF - 1) / NBUF);
        if (wid >= 2) {
            const GAS float* arr[4] = {(const GAS float*)W, (const GAS float*)Kb, (const GAS float*)AA, (const GAS float*)R};
            const GAS float* Vg = (const GAS float*)V;
            const f32x4 kk4 = *(const GAS f32x4*)(k_k + cbase + cl * 4), ka4 = *(const GAS f32x4*)(k_a + cbase + cl * 4), rk4 = *(const GAS f32x4*)(r_k + cbase + cl * 4);
            f32x4 pre[16]; float prev;
#define SCAN_LOAD(t0) do { _Pragma("unroll") for (int a = 0; a < 4; ++a) _Pragma("unroll") for (int i = 0; i < 4; ++i) \
                pre[a * 4 + i] = *(const GAS f32x4*)(arr[a] + (size_t)((t0) + 4 * i + rl) * D + cbase + cl * 4); \
                prev = Vg[(size_t)((t0) + (lane >> 2)) * D + cbase + rowbase + (lane & 3)]; } while (0)
            SCAN_LOAD(0);
            for (int c = 0; c < T / CH; ++c) {
                const int b = c % NBUF, g = c / NBUF;
                LAS float* buf = wbase + b * BUF_F;
                while (done[b] < ubase + g) __builtin_amdgcn_s_sleep(1);
                asm volatile("" ::: "memory");
                const int t0 = c * CH;
#pragma unroll
                for (int i = 0; i < 4; ++i) {
                    const f32x4 w_ = pre[0 + i], k_ = pre[4 + i], a_ = pre[8 + i], r_ = pre[12 + i];
                    f32x4 kk_ = k_ * kk4; const float ss_ = red16(kk_[0] * kk_[0] + kk_[1] * kk_[1] + kk_[2] * kk_[2] + kk_[3] * kk_[3]);
                    kk_ = kk_ * rsqrtf(fmaxf(ss_, 1e-24f));
                    const f32x4 kp_ = k_ * (1.f + (a_ - 1.f) * ka4); const f32x4 rk_ = r_ * kp_ * rk4;
                    const float bon_ = red16(rk_[0] + rk_[1] + rk_[2] + rk_[3]);
                    LAS float* sp_ = buf + ((4 * i + rl) * 5) * 64 + cl * 4;
                    *(LAS f32x4*)(sp_) = w_; *(LAS f32x4*)(sp_ + 64) = kp_; *(LAS f32x4*)(sp_ + 128) = -kk_; *(LAS f32x4*)(sp_ + 192) = kk_ * a_; *(LAS f32x4*)(sp_ + 256) = r_;
                    if (rowgrp == 0 && cl == 0) ((GAS float*)BON)[(size_t)(t0 + 4 * i + rl) * 32 + head] = bon_;
                }
                buf[CH * 320 + lane] = prev;
                if (c + 1 < T / CH) SCAN_LOAD((c + 1) * CH);
                asm volatile("s_waitcnt lgkmcnt(0)" ::: "memory");
                if (lane == 0) ready[b] = ubase + g + 1;
            }
#undef SCAN_LOAD
        } else {
            GAS float* Yg = (GAS float*)Y;
            f32x4 S = {0.f, 0.f, 0.f, 0.f};
            for (int c = 0; c < T / CH; ++c) {
                const int b = c % NBUF, g = c / NBUF;
                LAS float* cur = wbase + b * BUF_F;
                while (ready[b] < ubase + g + 1) __builtin_amdgcn_s_sleep(1);
                asm volatile("" ::: "memory");
                float yacc = 0.f;
                f32x4 w4, k4, a4, b4, r4; float v;
#define SCAN_RD(s_) do { const LAS float* sp = cur + (s_) * 320 + cl * 4; w4 = *(const LAS f32x4*)(sp); k4 = *(const LAS f32x4*)(sp + 64); a4 = *(const LAS f32x4*)(sp + 128); \
                    b4 = *(const LAS f32x4*)(sp + 192); r4 = *(const LAS f32x4*)(sp + 256); v = cur[CH * 320 + (s_) * 4 + rl]; } while (0)
                SCAN_RD(0);
                f32x4 pr = r4;
#pragma unroll
                for (int s = 0; s < CH; ++s) {
                    const f32x4 cw = w4, ck = k4, ca = a4, cb = b4, cr = r4; const float cv = v;
                    if (s + 1 < CH) SCAN_RD(s + 1);
                    __builtin_amdgcn_sched_barrier(0);
                    f32x2v ta = (f32x2v){S[0], S[1]} * (f32x2v){ca[0], ca[1]}; ta = (f32x2v){S[2], S[3]} * (f32x2v){ca[2], ca[3]} + ta;
                    f32x2v ty = (f32x2v){S[0], S[1]} * (f32x2v){pr[0], pr[1]}; ty = (f32x2v){S[2], S[3]} * (f32x2v){pr[2], pr[3]} + ty;
                    float sa = ta[0] + ta[1];
                    float y = ty[0] + ty[1];
                    const f32x4 cc = S * cw + cv * ck;
                    sa += dpp_f<0xB1>(sa); y += dpp_f<0xB1>(y);
                    sa += dpp_f<0x4E>(sa); y += dpp_f<0x4E>(y);
                    sa += dpp_f<0x141>(sa); y += dpp_f<0x141>(y);
                    sa += dpp_f<0x140>(sa); y += dpp_f<0x140>(y);
                    S = sa * cb + cc;
                    if (s > 0) yacc = (cl == s - 1) ? y : yacc;
                    pr = cr;
                    if (s == CH - 1) { asm volatile("s_waitcnt lgkmcnt(0)" ::: "memory"); if (lane == 0) done[b] = ubase + g + 1; }
                }
                {
                    float y = S[0] * pr[0] + S[1] * pr[1] + S[2] * pr[2] + S[3] * pr[3];
                    y = red16(y);
                    yacc = (cl == CH - 1) ? y : yacc;
                }
#undef SCAN_RD
                Yg[(size_t)(c * CH + cl) * D + cbase + rowbase + rl] = yacc;
            }
        }
    }
}

enum { EP_F32 = 0, EP_BF16, EP_TANH, EP_SIGM, EP_RELU2, EP_RESID, EP_DECAY, EP_SIGB, EP_VMIX, EP_Q, EP_GELU };
struct Job { const bf16_t* A; const bf16_t* Bt; void* out; const float* aux; const float* aux2; int nM, nN, ldc, mode, ustart, pad0; };
struct Unit { int pm, pn, job; };
constexpr int BM = 256, BK = 64, HALF = 128, HTB = HALF * BK * 2;
__device__ __forceinline__ int lds_byte(int r, int c) { const int st = (r >> 4) * 2 + (c >> 5), rr = r & 15, cc = c & 31, ob = rr * 64 + cc * 2; return st * 1024 + (ob ^ (((ob >> 9) & 1) << 5)); }
__device__ __forceinline__ void stage_rc(int b, int& R, int& C) { const int st = b / 1024, sb = b % 1024, swz = sb ^ (((sb >> 9) & 1) << 5); R = (st >> 1) * 16 + swz / 64; C = (st & 1) * 32 + (swz % 64) / 2; }

__device__ __forceinline__ bool next_unit(const LAS Job* jobs, int nj, int total, int i, Unit& u) {
    const long L = (long)i * gridDim.x + blockIdx.x;
    if (L >= total) return false;
    int j = 0;
    for (int q = 1; q < nj; ++q) if ((int)L >= jobs[q].ustart) j = q;
    const int nM = jobs[j].nM, nN = jobs[j].nN, nwg = nM * nN;
    int wgid = (int)L - jobs[j].ustart;
    { const int q = nwg / 8, r = nwg % 8, xcd = wgid % 8, off = wgid / 8; wgid = (xcd < r ? xcd * (q + 1) : r * (q + 1) + (xcd - r) * q) + off; }
    const int nig = 8 * nN, gid = wgid / nig, fm = gid * 8, gsz = (nM - fm) < 8 ? (nM - fm) : 8;
    u.pm = __builtin_amdgcn_readfirstlane(fm + ((wgid % nig) % gsz));
    u.pn = __builtin_amdgcn_readfirstlane((wgid % nig) / gsz);
    u.job = __builtin_amdgcn_readfirstlane(j);
    return true;
}

template <int MODE>
__device__ __forceinline__ void epi_t(const f32x4 (&acc)[2][2][4][2], void* outp, int ldc, const float* aux, const float* aux2, int pm, int pn, int wr, int wc, int fr, int fq) {
    const int row0 = pm * BM + wr * 64 + fr, col0 = pn * BM + wc * 32 + 4 * fq;
#pragma unroll
    for (int ai = 0; ai < 2; ++ai)
#pragma unroll
        for (int m = 0; m < 4; ++m) {
            const size_t row = (size_t)(row0 + ai * HALF + m * 16);
#pragma unroll
            for (int bj = 0; bj < 2; ++bj)
#pragma unroll
                for (int n = 0; n < 2; ++n) {
                    const int col = col0 + bj * HALF + n * 16;
                    f32x4 v = acc[ai][bj][m][n];
                    const size_t o = row * (size_t)ldc + col;
                    if constexpr (MODE == EP_F32) { *(f32x4*)((float*)outp + o) = v; }
                    else if constexpr (MODE == EP_BF16) { store_bf4((bf16_t*)outp + o, v); }
                    else if constexpr (MODE == EP_TANH) { v[0] = tanhf_(v[0]); v[1] = tanhf_(v[1]); v[2] = tanhf_(v[2]); v[3] = tanhf_(v[3]); store_bf4((bf16_t*)outp + o, v); }
                    else if constexpr (MODE == EP_SIGM) { v[0] = sigmoidf_(v[0]); v[1] = sigmoidf_(v[1]); v[2] = sigmoidf_(v[2]); v[3] = sigmoidf_(v[3]); store_bf4((bf16_t*)outp + o, v); }
                    else if constexpr (MODE == EP_RELU2) { v[0] = fmaxf(v[0], 0.f); v[1] = fmaxf(v[1], 0.f); v[2] = fmaxf(v[2], 0.f); v[3] = fmaxf(v[3], 0.f); store_bf4((bf16_t*)outp + o, v * v); }
                    else if constexpr (MODE == EP_RESID) { f32x4* hp = (f32x4*)((float*)outp + o); *hp = *hp + v; }
                    else if constexpr (MODE == EP_DECAY) {
                        const f32x4 x = v + *(const f32x4*)(aux + col);
#pragma unroll
                        for (int j = 0; j < 4; ++j) { const float z = -x[j]; const float sp = fmaxf(z, 0.f) + log1pf(__expf(-fabsf(z))); v[j] = __expf(-__expf(-sp - 0.5f)); }
                        *(f32x4*)((float*)outp + o) = v;
                    }
                    else if constexpr (MODE == EP_SIGB) {
                        const f32x4 x = v + *(const f32x4*)(aux + col);
                        v[0] = sigmoidf_(x[0]); v[1] = sigmoidf_(x[1]); v[2] = sigmoidf_(x[2]); v[3] = sigmoidf_(x[3]);
                        *(f32x4*)((float*)outp + o) = v;
                    }
                    else if constexpr (MODE == EP_VMIX) {
                        const f32x4 x = v + *(const f32x4*)(aux + col);
                        const f32x4 vf = *(const f32x4*)(aux2 + o); f32x4 vv = *(const f32x4*)((float*)outp + o);
#pragma unroll
                        for (int j = 0; j < 4; ++j) vv[j] = vv[j] + (vf[j] - vv[j]) * sigmoidf_(x[j]);
                        *(f32x4*)((float*)outp + o) = vv;
                    }
                    else if constexpr (MODE == EP_Q) {
                        if (col < 2048) { store_bf4((bf16_t*)outp + row * 2048 + col, v * 0.08838834764831845f); }
                        else if (col < 2096) { v[0] = sigmoidf_(v[0]); v[1] = sigmoidf_(v[1]); v[2] = sigmoidf_(v[2]); v[3] = sigmoidf_(v[3]); *(f32x4*)((float*)aux + row * 48 + (col - 2048)) = v; }
                    }
                    else if constexpr (MODE == EP_GELU) {
                        const f32x4 x = v + *(const f32x4*)(aux + col);
#pragma unroll
                        for (int j = 0; j < 4; ++j) { const float xx = x[j]; v[j] = 0.5f * xx * (1.f + tanhf_(0.7978845608028654f * (xx + 0.044715f * xx * xx * xx))); }
                        store_bf4((bf16_t*)outp + o, v);
                    }
                }
        }
}
__device__ __forceinline__ void epilogue(const f32x4 (&acc)[2][2][4][2], const LAS Job* jb, int pm, int pn, int wr, int wc, int fr, int fq) {
    void* outp = jb->out; const int ldc = jb->ldc, mode = __builtin_amdgcn_readfirstlane(jb->mode); const float* aux = jb->aux; const float* aux2 = jb->aux2;
    switch (mode) {
        case EP_F32: epi_t<EP_F32>(acc, outp, ldc, aux, aux2, pm, pn, wr, wc, fr, fq); break;
        case EP_BF16: epi_t<EP_BF16>(acc, outp, ldc, aux, aux2, pm, pn, wr, wc, fr, fq); break;
        case EP_TANH: epi_t<EP_TANH>(acc, outp, ldc, aux, aux2, pm, pn, wr, wc, fr, fq); break;
        case EP_SIGM: epi_t<EP_SIGM>(acc, outp, ldc, aux, aux2, pm, pn, wr, wc, fr, fq); break;
        case EP_RELU2: epi_t<EP_RELU2>(acc, outp, ldc, aux, aux2, pm, pn, wr, wc, fr, fq); break;
        case EP_RESID: epi_t<EP_RESID>(acc, outp, ldc, aux, aux2, pm, pn, wr, wc, fr, fq); break;
        case EP_DECAY: epi_t<EP_DECAY>(acc, outp, ldc, aux, aux2, pm, pn, wr, wc, fr, fq); break;
        case EP_SIGB: epi_t<EP_SIGB>(acc, outp, ldc, aux, aux2, pm, pn, wr, wc, fr, fq); break;
        case EP_VMIX: epi_t<EP_VMIX>(acc, outp, ldc, aux, aux2, pm, pn, wr, wc, fr, fq); break;
        case EP_Q: epi_t<EP_Q>(acc, outp, ldc, aux, aux2, pm, pn, wr, wc, fr, fq); break;
        default: epi_t<EP_GELU>(acc, outp, ldc, aux, aux2, pm, pn, wr, wc, fr, fq); break;
    }
}

__device__ __forceinline__ void gemm_phase(LAS unsigned char* lds, const LAS Job* jobs, int nj, int total, int K, int lda, int ldb) {
    const int tid = ltid(), wid = __builtin_amdgcn_readfirstlane(tid >> 6), lane = tid & 63, wr = wid >> 2, wc = wid & 3, fr = lane & 15, fq = lane >> 4;
    const int nt = K / BK;
    unsigned voffA[2], voffB[2];
#pragma unroll
    for (int i = 0; i < 2; ++i) { int R, C; stage_rc(tid * 16 + i * 8192, R, C); voffA[i] = (unsigned)(R * lda + C) * 2u; voffB[i] = (unsigned)(R * ldb + C) * 2u; }
    const size_t kstep = (size_t)(BK * 2);
    const size_t hstepA = (size_t)HALF * lda * 2, hstepB = (size_t)HALF * ldb * 2;
    const size_t tstepA = 2 * hstepA, tstepB = 2 * hstepB;
    const unsigned ldsw = (unsigned)wid * 1024u;
    const int aoff = lds_byte(wr * 64 + fr, fq * 8), boff = lds_byte(wc * 32 + fr, fq * 8);
#define PG8_SA(b, h) (((b) * 2 + (h)) * HTB)
#define PG8_SB(b, h) ((4 + (b) * 2 + (h)) * HTB)
#define PG8_STAGE(bufoff, gbase, voff) do { _Pragma("unroll") for (int _i = 0; _i < 2; ++_i) \
        __builtin_amdgcn_global_load_lds((const unsigned*)((const char*)(gbase) + (voff)[_i]), (LAS unsigned*)(lds + (bufoff) + ldsw + _i * 8192), 16, 0, 0); } while (0)
#define PG8_LDA(dst, b, h) do { _Pragma("unroll") for (int m = 0; m < 4; ++m) _Pragma("unroll") for (int k = 0; k < 2; ++k) dst[m][k] = *(const LAS bf16x8*)(lds + PG8_SA(b, h) + aoff + m * 2048 + k * 1024); } while (0)
#define PG8_LDB(dst, b, h) do { _Pragma("unroll") for (int n = 0; n < 2; ++n) _Pragma("unroll") for (int k = 0; k < 2; ++k) dst[n][k] = *(const LAS bf16x8*)(lds + PG8_SB(b, h) + boff + n * 2048 + k * 1024); } while (0)
#define PG8_MMA(ai, bj, At, Bt) do { __builtin_amdgcn_s_setprio(1); _Pragma("unroll") for (int m = 0; m < 4; ++m) _Pragma("unroll") for (int n = 0; n < 2; ++n) _Pragma("unroll") for (int k = 0; k < 2; ++k) \
        acc[ai][bj][m][n] = __builtin_amdgcn_mfma_f32_16x16x32_bf16(Bt[n][k], At[m][k], acc[ai][bj][m][n], 0, 0, 0); __builtin_amdgcn_s_setprio(0); } while (0)
#define PG8_WAIT_V(n) asm volatile("s_waitcnt vmcnt(" #n ")" ::: "memory")
#define PG8_WAIT_L(n) asm volatile("s_waitcnt lgkmcnt(" #n ")" ::: "memory")
#define PG8_BAR __builtin_amdgcn_s_barrier()
#define PG8_SCHED __builtin_amdgcn_sched_barrier(0)
    Unit cur, nxt; int ui = 0;
    if (!next_unit(jobs, nj, total, 0, cur)) return;
    f32x4 acc[2][2][4][2];
#pragma unroll
    for (int a = 0; a < 2; ++a)
#pragma unroll
        for (int b = 0; b < 2; ++b)
#pragma unroll
            for (int m = 0; m < 4; ++m)
#pragma unroll
                for (int n = 0; n < 2; ++n) acc[a][b][m][n] = (f32x4){0.f, 0.f, 0.f, 0.f};
    bf16x8 At[4][2], B0[2][2], B1[2][2];
    const char* cA = (const char*)jobs[cur.job].A + (size_t)cur.pm * tstepA; const char* cB = (const char*)jobs[cur.job].Bt + (size_t)cur.pn * tstepB;
    PG8_STAGE(PG8_SB(0, 0), cB, voffB); PG8_STAGE(PG8_SA(0, 0), cA, voffA); PG8_STAGE(PG8_SB(0, 1), cB + hstepB, voffB); PG8_STAGE(PG8_SA(0, 1), cA + hstepA, voffA);
    if (wr == 1) PG8_BAR;
    PG8_WAIT_V(4); PG8_BAR;
    PG8_STAGE(PG8_SB(1, 0), cB + kstep, voffB); PG8_STAGE(PG8_SA(1, 0), cA + kstep, voffA); PG8_STAGE(PG8_SB(1, 1), cB + hstepB + kstep, voffB);
    PG8_WAIT_V(6); PG8_BAR;
    for (;;) {
        const bool has_next = next_unit(jobs, nj, total, ui + 1, nxt);
        const char* nA = has_next ? (const char*)jobs[nxt.job].A + (size_t)nxt.pm * tstepA : cA; const char* nB = has_next ? (const char*)jobs[nxt.job].Bt + (size_t)nxt.pn * tstepB : cB;
        for (int t = 0; t < nt; t += 2) {
            const bool last = (t == nt - 2);
            const char* a1 = cA + (size_t)(t + 1) * kstep;
            const char* a2 = last ? nA : cA + (size_t)(t + 2) * kstep; const char* b2 = last ? nB : cB + (size_t)(t + 2) * kstep;
            const char* a3 = a2 + kstep; const char* b3 = b2 + kstep;
            PG8_LDB(B0, 0, 0); PG8_SCHED; PG8_LDA(At, 0, 0); PG8_STAGE(PG8_SA(1, 1), a1 + hstepA, voffA);
            PG8_WAIT_L(8); PG8_BAR; PG8_WAIT_L(0); PG8_MMA(0, 0, At, B0); PG8_BAR; PG8_SCHED;
            PG8_LDB(B1, 0, 1); PG8_STAGE(PG8_SB(0, 0), b2, voffB);
            PG8_BAR; PG8_WAIT_L(0); PG8_MMA(0, 1, At, B1); PG8_BAR;
            PG8_LDA(At, 0, 1); PG8_STAGE(PG8_SA(0, 0), a2, voffA);
            PG8_BAR; PG8_WAIT_L(0); PG8_MMA(1, 0, At, B0); PG8_BAR; PG8_SCHED;
            PG8_STAGE(PG8_SB(0, 1), b2 + hstepB, voffB);
            PG8_WAIT_V(6); PG8_BAR; PG8_MMA(1, 1, At, B1); PG8_BAR;
            PG8_LDB(B0, 1, 0); PG8_SCHED; PG8_LDA(At, 1, 0); PG8_STAGE(PG8_SA(0, 1), a2 + hstepA, voffA);
            PG8_WAIT_L(8); PG8_BAR; PG8_WAIT_L(0); PG8_MMA(0, 0, At, B0); PG8_BAR; PG8_SCHED;
            PG8_LDB(B1, 1, 1); PG8_STAGE(PG8_SB(1, 0), b3, voffB);
            PG8_BAR; PG8_WAIT_L(0); PG8_MMA(0, 1, At, B1); PG8_BAR;
            PG8_LDA(At, 1, 1); PG8_STAGE(PG8_SA(1, 0), a3, voffA);
            PG8_BAR; PG8_WAIT_L(0); PG8_MMA(1, 0, At, B0); PG8_BAR; PG8_SCHED;
            PG8_STAGE(PG8_SB(1, 1), b3 + hstepB, voffB);
            PG8_WAIT_V(6); PG8_BAR; PG8_MMA(1, 1, At, B1); PG8_BAR;
        }
        epilogue(acc, jobs + cur.job, cur.pm, cur.pn, wr, wc, fr, fq);
        if (!has_next) break;
#pragma unroll
        for (int a = 0; a < 2; ++a)
#pragma unroll
            for (int b = 0; b < 2; ++b)
#pragma unroll
                for (int m = 0; m < 4; ++m)
#pragma unroll
                    for (int n = 0; n < 2; ++n) acc[a][b][m][n] = (f32x4){0.f, 0.f, 0.f, 0.f};
        cur = nxt; cA = nA; cB = nB; ++ui;
    }
    PG8_WAIT_V(0);
    if (wr == 0) PG8_BAR;
    PG8_BAR;
#undef PG8_SA
#undef PG8_SB
#undef PG8_STAGE
#undef PG8_LDA
#undef PG8_LDB
#undef PG8_MMA
#undef PG8_WAIT_V
#undef PG8_WAIT_L
#undef PG8_BAR
#undef PG8_SCHED
}

__device__ __forceinline__ int t5_bucket_dev(int n) { if (n < 16) return n; int b = 16 + (int)(logf((float)n * 0.0625f) / 2.0794415416798357f * 16.0f); return b > 31 ? 31 : b; }

constexpr int KROW = 272, VROW = 144, KTILE_B = 64 * KROW, VTILE_B = 128 * VROW;
template <int BR, int NT>
__device__ __forceinline__ void flash_chunk(const bool FAST, const bf16x8 (&qf)[NT][4], float (&m)[NT], float (&l)[NT], f32x4 (&O)[NT][8], const LAS unsigned char* kl, const LAS unsigned char* vl,
                                            const int (&t)[NT], int key0, const LAS float* mylut, const bool (&selbit)[NT], float inv_l, volatile LAS float* myimp, int lane) {
    const int tok = lane & 15, q = lane >> 4;
    f32x4 S[NT][4];
#pragma unroll
    for (int mt = 0; mt < 4; ++mt) {
#pragma unroll
        for (int nt = 0; nt < NT; ++nt) S[nt][mt] = (f32x4){0.f, 0.f, 0.f, 0.f};
        const LAS unsigned char* kr = kl + (mt * 16 + tok) * KROW + q * 16;
#pragma unroll
        for (int kk = 0; kk < 4; ++kk) {
            const bf16x8 a = *(const LAS bf16x8*)(kr + kk * 64);
#pragma unroll
            for (int nt = 0; nt < NT; ++nt) S[nt][mt] = __builtin_amdgcn_mfma_f32_16x16x32_bf16(a, qf[nt][kk], S[nt][mt], 0, 0, 0);
        }
    }
#pragma unroll
    for (int nt = 0; nt < NT; ++nt) {
        float mx = -1e30f;
        if (FAST) {
            const float cbias = mylut[128];
#pragma unroll
            for (int mt = 0; mt < 4; ++mt)
#pragma unroll
                for (int j = 0; j < 4; ++j) { const float s = S[nt][mt][j] + cbias; S[nt][mt][j] = s; mx = fmaxf(mx, s); }
            if (BR == 2 && !selbit[nt]) mx = -1e30f;
        } else {
#pragma unroll
            for (int mt = 0; mt < 4; ++mt)
#pragma unroll
                for (int j = 0; j < 4; ++j) {
                    const int kidx = mt * 16 + q * 4 + j; int dist; bool v;
                    if (BR <= 1) { dist = t[nt] - (16 * (key0 + kidx) + 31); v = dist >= 0; }
                    else if (BR == 2) { dist = t[nt] - (key0 + kidx); v = (dist >= 0) && selbit[nt]; }
                    else { dist = t[nt] - (key0 + kidx); v = (dist >= 0) && (dist < 512); }
                    const int di = dist < 0 ? 0 : (dist > 128 ? 128 : dist);
                    float s = S[nt][mt][j] + mylut[di];
                    s = v ? s : -1e30f; S[nt][mt][j] = s; mx = fmaxf(mx, s);
                }
        }
        float mnew, alpha;
        if (BR == 1) { mnew = m[nt]; alpha = 1.f; }
        else { mx = xmax4(mx); mnew = fmaxf(m[nt], mx); alpha = __expf(m[nt] - mnew); }
        float rs = 0.f;
        if (FAST) {
            const bool v = (BR != 2) || selbit[nt];
#pragma unroll
            for (int mt = 0; mt < 4; ++mt)
#pragma unroll
                for (int j = 0; j < 4; ++j) { const float p = v ? __expf(S[nt][mt][j] - mnew) : 0.f; S[nt][mt][j] = p; rs += p; }
        } else {
#pragma unroll
            for (int mt = 0; mt < 4; ++mt)
#pragma unroll
                for (int j = 0; j < 4; ++j) { const float s = S[nt][mt][j]; const float p = (s > -1e29f) ? __expf(s - mnew) : 0.f; S[nt][mt][j] = p; rs += p; }
        }
        rs = xsum4(rs);
        l[nt] = l[nt] * alpha + rs; m[nt] = mnew;
        if (BR >= 2) {
            if (__ballot(alpha != 1.f) != 0ull) {
#pragma unroll
                for (int dt = 0; dt < 8; ++dt) O[nt][dt] = O[nt][dt] * alpha;
            }
        }
    }
    if (BR == 0) return;
    if (BR == 1) {
        const int u0 = tok * 132 + (key0 >> 2) + q;
#pragma unroll
        for (int mt = 0; mt < 4; ++mt) { const float s4 = (S[0][mt][0] + S[0][mt][1] + S[0][mt][2] + S[0][mt][3]) * inv_l; myimp[u0 + mt * 4] = myimp[u0 + mt * 4] + s4; }
        wave_fence();
#pragma unroll
        for (int mt = 0; mt < 4; ++mt) { const float p3 = S[0][mt][3] * inv_l; myimp[u0 + mt * 4 + 1] = myimp[u0 + mt * 4 + 1] + p3; }
        wave_fence();
    }
#pragma unroll
    for (int i = 0; i < 2; ++i) {
        union { u32x4 u; bf16x8 b; } pb[NT];
#pragma unroll
        for (int nt = 0; nt < NT; ++nt) {
            pb[nt].u.x = cvt_pk_bf16(S[nt][2 * i][0], S[nt][2 * i][1]); pb[nt].u.y = cvt_pk_bf16(S[nt][2 * i][2], S[nt][2 * i][3]);
            pb[nt].u.z = cvt_pk_bf16(S[nt][2 * i + 1][0], S[nt][2 * i + 1][1]); pb[nt].u.w = cvt_pk_bf16(S[nt][2 * i + 1][2], S[nt][2 * i + 1][3]);
        }
#pragma unroll
        for (int dt = 0; dt < 8; ++dt) {
            const LAS unsigned char* vr = vl + (dt * 16 + tok) * VROW + (32 * i + 4 * q) * 2;
            union { struct { u32x2 lo, hi; } s; bf16x8 b; } va;
            va.s.lo = *(const LAS u32x2*)vr; va.s.hi = *(const LAS u32x2*)(vr + 32);
#pragma unroll
            for (int nt = 0; nt < NT; ++nt) O[nt][dt] = __builtin_amdgcn_mfma_f32_16x16x32_bf16(va.b, pb[nt].b, O[nt][dt], 0, 0, 0);
        }
    }
}
__device__ __forceinline__ void kv_load(u32x4 (&r)[4], const bf16_t* __restrict__ kb, int kstride, const bf16_t* __restrict__ vb, int vtstride, bool needv, int tid) {
#pragma unroll
    for (int j = 0; j < 2; ++j) { const unsigned p = (unsigned)tid + 512u * j; const unsigned off = (p >> 4) * (unsigned)kstride + (p & 15u) * 8u; r[j] = *(const GAS u32x4*)(kb + off); }
    if (needv) {
#pragma unroll
        for (int j = 0; j < 2; ++j) { const unsigned p = (unsigned)tid + 512u * j; const unsigned off = (p >> 3) * (unsigned)vtstride + (p & 7u) * 8u; r[2 + j] = *(const GAS u32x4*)(vb + off); }
    }
}
__device__ __forceinline__ void kv_store(const u32x4 (&r)[4], LAS unsigned char* kl, LAS unsigned char* vl, bool needv, int tid) {
#pragma unroll
    for (int j = 0; j < 2; ++j) { const int p = tid + 512 * j; *(LAS u32x4*)(kl + (p >> 4) * KROW + (p & 15) * 16) = r[j]; }
    if (needv) {
#pragma unroll
        for (int j = 0; j < 2; ++j) { const int p = tid + 512 * j; *(LAS u32x4*)(vl + (p >> 3) * VROW + (p & 7) * 16) = r[2 + j]; }
    }
}
template <int BR, int NT>
__device__ __forceinline__ void branch_step(int i, int n, const LAS int* clist, const bf16_t* __restrict__ kbase0, int kstride, const bf16_t* __restrict__ vbase0, int vtstride,
                                            const bf16x8 (&qf)[NT][4], float (&m)[NT], float (&l)[NT], f32x4 (&O)[NT][8], const int (&t)[NT], int t0w, const LAS float* mylut, const LAS unsigned* mymask,
                                            float inv_l, volatile LAS float* myimp, LAS unsigned char* ck, LAS unsigned char* cv, LAS unsigned char* nk, LAS unsigned char* nv, int tid, int lane) {
    u32x4 r[4];
    const int c = __builtin_amdgcn_readfirstlane(clist[i]);
    if (i + 1 < n) { const int cn = __builtin_amdgcn_readfirstlane(clist[i + 1]); kv_load(r, kbase0 + (size_t)cn * 64 * kstride, kstride, vbase0 + cn * 64, vtstride, BR != 0, tid); }
    bool bit[NT]; bool any = true;
    if (BR == 2) {
        any = false;
#pragma unroll
        for (int nt = 0; nt < NT; ++nt) { const unsigned w = mymask[nt * 64 + (c >> 5)]; bit[nt] = (w >> (c & 31)) & 1u; any = any || bit[nt]; }
    } else {
#pragma unroll
        for (int nt = 0; nt < NT; ++nt) bit[nt] = true;
    }
    if (BR != 2 || __ballot(any) != 0ull) {
        bool far = false;
        if (BR <= 1) far = (t0w - (16 * (c * 64 + 63) + 31)) >= 128;
        else if (BR == 2) far = (t0w - (c * 64 + 63)) >= 128;
        flash_chunk<BR, NT>(far, qf, m, l, O, ck, cv, t, c * 64, mylut, bit, inv_l, myimp, lane);
    }
    if (BR >= 2) {
        if (i + 1 < n) kv_store(r, nk, nv, true, tid);
        __syncthreads();
    } else {
        __syncthreads();
        if (i + 1 < n) kv_store(r, nk, nv, BR != 0, tid);
        __syncthreads();
    }
}
template <int BR, int NT>
__device__ __forceinline__ void run_branch(const LAS int* clist, int n, const bf16_t* __restrict__ kbase0, int kstride, const bf16_t* __restrict__ vbase0, int vtstride,
                                           const bf16x8 (&qf)[NT][4], float (&m)[NT], float (&l)[NT], f32x4 (&O)[NT][8], const int (&t)[NT], const LAS float* mylut, const LAS unsigned* mymask,
                                           float inv_l, volatile LAS float* myimp, LAS unsigned char* kl, LAS unsigned char* vl, LAS unsigned char* kl1, LAS unsigned char* vl1, int tid, int lane) {
    if (n == 0) return;
    asm volatile("" : "+v"(tid), "+v"(lane));
    {
        u32x4 r[4];
        const int c = clist[0];
        kv_load(r, kbase0 + (size_t)c * 64 * kstride, kstride, vbase0 + c * 64, vtstride, BR != 0, tid);
        kv_store(r, kl, vl, BR != 0, tid);
    }
    __syncthreads();
    const int t0w = __builtin_amdgcn_readfirstlane(t[0]);
    if (BR >= 2) {
        for (int i = 0; i < n; i += 2) {
            branch_step<BR, NT>(i, n, clist, kbase0, kstride, vbase0, vtstride, qf, m, l, O, t, t0w, mylut, mymask, inv_l, myimp, kl, vl, kl1, vl1, tid, lane);
            if (i + 1 < n) branch_step<BR, NT>(i + 1, n, clist, kbase0, kstride, vbase0, vtstride, qf, m, l, O, t, t0w, mylut, mymask, inv_l, myimp, kl1, vl1, kl, vl, tid, lane);
        }
    } else {
        for (int i = 0; i < n; ++i)
            branch_step<BR, NT>(i, n, clist, kbase0, kstride, vbase0, vtstride, qf, m, l, O, t, t0w, mylut, mymask, inv_l, myimp, kl, vl, kl, vl, tid, lane);
    }
}

__device__ __forceinline__ void phase_attn(const bf16_t* __restrict__ Q, const float* __restrict__ GATES, const bf16_t* __restrict__ KV, const bf16_t* __restrict__ VTS,
                           const bf16_t* __restrict__ VTW, const bf16_t* __restrict__ KC, const bf16_t* __restrict__ VCT, const float* __restrict__ relb,
                           bf16_t* __restrict__ Oo, LAS unsigned char* lds) {
    LAS float* lut = (LAS float*)lds;
    LAS float* impw = lut + 4 * 132;
    LAS float* comb = impw + 8 * 16 * 132;
    LAS unsigned* selm = (LAS unsigned*)(comb + 8 * 128);
    LAS int* clist = (LAS int*)(selm + 64 * 4);
    LAS unsigned char* kl = (LAS unsigned char*)(clist + 128);
    LAS unsigned char* vl = kl + KTILE_B;
    LAS unsigned char* kl1 = (LAS unsigned char*)impw;
    LAS unsigned char* vl1 = kl1 + KTILE_B;
    for (int idx = blockIdx.x; idx < 512; idx += gridDim.x) {
        const int tid = ltid(), wid = tid >> 6, lane = tid & 63, r = wid & 3, sub = wid >> 2, tok = lane & 15, q = lane >> 4;
        LAS float* myimp = impw + wid * 16 * 132;
        const LAS float* mylut = lut + r * 132;
        const int g = idx & 3, jj = idx >> 2, tt = (jj < 64) ? 127 - jj : jj - 64, h = g * 4 + r;
        __syncthreads();
        for (int e = tid; e < 4 * 129; e += 512) { const int rr = e / 129, n = e % 129; lut[rr * 132 + n] = relb[t5_bucket_dev(n) * 16 + g * 4 + rr]; }
        for (int half = 0; half < 2; ++half) {
            const int tt32 = tt * 2 + half;
            int t1[1]; t1[0] = tt32 * 32 + sub * 16 + tok;
            const int t = t1[0];
            __syncthreads();
            for (int e = lane; e < 16 * 132; e += 64) myimp[e] = 0.f;
            const int nch = ((2 * tt32) >> 6) + 1;
            if (tid < 128) clist[tid] = tid;
            __syncthreads();
            bf16x8 qf[1][4];
#pragma unroll
            for (int kk = 0; kk < 4; ++kk) qf[0][kk] = *(const bf16x8*)(Q + (size_t)t * 2048 + h * 128 + kk * 32 + q * 8);
            f32x4 O[1][8]; float m[1], l[1];
            m[0] = -1e30f; l[0] = 0.f;
            run_branch<0, 1>(clist, nch, KC + (size_t)(g * 512) * 256, 256, VCT + g * 512, 2048, qf, m, l, O, t1, mylut, nullptr, 0.f, myimp, kl, vl, kl1, vl1, tid, lane);
            const float inv_l = l[0] > 0.f ? 1.f / l[0] : 0.f;
            l[0] = 0.f;
#pragma unroll
            for (int dt = 0; dt < 8; ++dt) O[0][dt] = (f32x4){0.f, 0.f, 0.f, 0.f};
            run_branch<1, 1>(clist, nch, KC + (size_t)(g * 512) * 256, 256, VCT + g * 512, 2048, qf, m, l, O, t1, mylut, nullptr, inv_l, myimp, kl, vl, kl1, vl1, tid, lane);
            { const float g0 = GATES[(size_t)t * 48 + g * 12 + r * 3 + 0];
#pragma unroll
              for (int dt = 0; dt < 8; ++dt) store_bf4(Oo + (size_t)t * 2048 + h * 128 + dt * 16 + q * 4, O[0][dt] * (inv_l * g0)); }
            __syncthreads();
            {
                LAS float* cb = comb + wid * 128;
                for (int i = 0; i < 4; ++i) {
                    const int tk = wid * 4 + i, sb = tk >> 4, row = tk & 15, tq = tt32 * 32 + tk, cur = tq >> 6;
                    float v0 = 0.f, v1 = 0.f;
#pragma unroll
                    for (int rr = 0; rr < 4; ++rr) { const LAS float* ip = impw + ((sb * 4 + rr) * 16 + row) * 132; v0 += ip[lane]; v1 += ip[lane + 64]; }
                    cb[lane] = v0; cb[lane + 64] = v1;
                    wave_fence();
                    bool sel0, sel1;
                    if (cur + 1 <= 16) { sel0 = lane <= cur; sel1 = false; }
                    else {
                        int cnt0 = 0, cnt1 = 0;
                        for (int s2 = 1; s2 < cur; ++s2) {
                            const float x = ((volatile LAS float*)cb)[s2];
                            cnt0 += ((x > v0) || (x == v0 && s2 < lane)) ? 1 : 0;
                            cnt1 += ((x > v1) || (x == v1 && s2 < lane + 64)) ? 1 : 0;
                        }
                        const int s0 = lane, s1 = lane + 64;
                        sel0 = (s0 == 0) || (s0 == cur) || (s0 < cur && cnt0 < 14);
                        sel1 = (s1 == cur) || (s1 < cur && cnt1 < 14);
                    }
                    const unsigned long long b0 = __ballot(sel0), b1 = __ballot(sel1);
                    const int ts = half * 32 + tk;
                    if (lane == 0) { selm[ts * 4 + 0] = (unsigned)b0; selm[ts * 4 + 1] = (unsigned)(b0 >> 32); selm[ts * 4 + 2] = (unsigned)b1; selm[ts * 4 + 3] = (unsigned)(b1 >> 32); }
                    wave_fence();
                }
            }
        }
        __syncthreads();
        const int smax = tt;
        if (tid == 0) {
            unsigned u0 = 0, u1 = 0, u2 = 0, u3 = 0;
            for (int k = 0; k < 64; ++k) { u0 |= selm[k * 4 + 0]; u1 |= selm[k * 4 + 1]; u2 |= selm[k * 4 + 2]; u3 |= selm[k * 4 + 3]; }
            int n = 0;
            for (int s = 0; s <= smax; ++s) { const unsigned w = s < 32 ? u0 : (s < 64 ? u1 : (s < 96 ? u2 : u3)); if ((w >> (s & 31)) & 1u) clist[n++] = s; }
            clist[127] = n;
        }
        __syncthreads();
        const int nsel = clist[127];
        {
            const int th = sub;
            int t2[2]; t2[0] = tt * 64 + th * 32 + tok; t2[1] = t2[0] + 16;
            bf16x8 qf[2][4];
#pragma unroll
            for (int nt = 0; nt < 2; ++nt)
#pragma unroll
                for (int kk = 0; kk < 4; ++kk) qf[nt][kk] = *(const bf16x8*)(Q + (size_t)t2[nt] * 2048 + h * 128 + kk * 32 + q * 8);
            f32x4 O[2][8]; float m[2], l[2];
            m[0] = -1e30f; m[1] = -1e30f; l[0] = 0.f; l[1] = 0.f;
#pragma unroll
            for (int nt = 0; nt < 2; ++nt)
#pragma unroll
                for (int dt = 0; dt < 8; ++dt) O[nt][dt] = (f32x4){0.f, 0.f, 0.f, 0.f};
            run_branch<2, 2>(clist, nsel, KV + 1024 + g * 128, 3072, VTS + (size_t)(g * 128) * 8192, 8192, qf, m, l, O, t2, mylut, selm + (th * 32 + tok) * 4, 0.f, myimp, kl, vl, kl1, vl1, tid, lane);
#pragma unroll
            for (int nt = 0; nt < 2; ++nt) {
                const float sc = l[nt] > 0.f ? GATES[(size_t)t2[nt] * 48 + g * 12 + r * 3 + 1] / l[nt] : 0.f;
#pragma unroll
                for (int dt = 0; dt < 8; ++dt) {
                    bf16_t* op = Oo + (size_t)t2[nt] * 2048 + h * 128 + dt * 16 + q * 4;
                    const u32x2 w = *(const u32x2*)op;
                    f32x4 v = O[nt][dt] * sc;
                    v[0] += __uint_as_float(w.x << 16); v[1] += __uint_as_float(w.x & 0xffff0000u); v[2] += __uint_as_float(w.y << 16); v[3] += __uint_as_float(w.y & 0xffff0000u);
                    store_bf4(op, v);
                }
                __builtin_amdgcn_sched_barrier(0);
            }
            const int lo = (tt * 64 - 511 > 0 ? tt * 64 - 511 : 0) >> 6, hi = smax;
            if (tid <= hi - lo) clist[tid] = lo + tid;
            __syncthreads();
            m[0] = -1e30f; m[1] = -1e30f; l[0] = 0.f; l[1] = 0.f;
#pragma unroll
            for (int nt = 0; nt < 2; ++nt)
#pragma unroll
                for (int dt = 0; dt < 8; ++dt) O[nt][dt] = (f32x4){0.f, 0.f, 0.f, 0.f};
            run_branch<3, 2>(clist, hi - lo + 1, KV + 2048 + g * 128, 3072, VTW + (size_t)(g * 128) * 8192, 8192, qf, m, l, O, t2, mylut, nullptr, 0.f, myimp, kl, vl, kl1, vl1, tid, lane);
#pragma unroll
            for (int nt = 0; nt < 2; ++nt) {
                const float sc = l[nt] > 0.f ? GATES[(size_t)t2[nt] * 48 + g * 12 + r * 3 + 2] / l[nt] : 0.f;
#pragma unroll
                for (int dt = 0; dt < 8; ++dt) {
                    bf16_t* op = Oo + (size_t)t2[nt] * 2048 + h * 128 + dt * 16 + q * 4;
                    const u32x2 w = *(const u32x2*)op;
                    f32x4 v = O[nt][dt] * sc;
                    v[0] += __uint_as_float(w.x << 16); v[1] += __uint_as_float(w.x & 0xffff0000u); v[2] += __uint_as_float(w.y << 16); v[3] += __uint_as_float(w.y & 0xffff0000u);
                    store_bf4(op, v);
                }
                __builtin_amdgcn_sched_barrier(0);
            }
        }
    }
}

enum { K_NC = 0, K_MIX, K_GEMM, K_PREP, K_SCAN, K_POST, K_IM2COL, K_ATTN };
#ifndef REP_KIND
#define REP_KIND (-1)
#endif
constexpr int NPH = 37, MAX_JOBS = 44, MAX_CONV = 40;
struct PhaseDesc { int kind, njobs, jfirst, total, K, lda, ldb, nconv, cfirst, sub, pad0, pad1; const void* ptr[10]; };
static_assert(sizeof(PhaseDesc) == 128 && NPH * 128 <= LDS_JOBS - LDS_DESC, "desc table");
static_assert(sizeof(Job) == 64 && MAX_JOBS * 64 <= LDS_CONV - LDS_JOBS, "job table");
static_assert(sizeof(Conv) == 32 && MAX_CONV * 32 <= LDS_WORK - LDS_CONV, "conv table");
struct Builder {
    LAS PhaseDesc* pd; LAS Job* jobs; LAS Conv* cv; int nph, nj, nc;
    __device__ __forceinline__ LAS PhaseDesc* phase(int kind) {
        __builtin_amdgcn_sched_barrier(0);
        LAS PhaseDesc* d = pd + nph; ++nph;
        d->kind = kind; d->njobs = 0; d->jfirst = nj; d->total = 0; d->K = D; d->lda = D; d->ldb = D; d->nconv = 0; d->cfirst = nc; d->sub = 0; d->pad0 = (kind == K_PREP) ? 0 : 1; d->pad1 = 0;
#pragma unroll
        for (int i = 0; i < 10; ++i) d->ptr[i] = nullptr;
        return d;
    }
    __device__ __forceinline__ void job(LAS PhaseDesc* d, const void* A, const void* Bt, void* out, const void* aux, const void* aux2, int nM, int nN, int ldc, int mode) {
        __builtin_amdgcn_sched_barrier(0);
        LAS Job* j = jobs + nj; ++nj;
        j->A = (const bf16_t*)A; j->Bt = (const bf16_t*)Bt; j->out = out; j->aux = (const float*)aux; j->aux2 = (const float*)aux2;
        j->nM = nM; j->nN = nN; j->ldc = ldc; j->mode = mode; j->ustart = d->total; j->pad0 = 0;
        d->total = d->total + nM * nN; d->njobs = d->njobs + 1; if (mode == EP_RESID || mode == EP_VMIX) d->pad0 = 0;
    }
    __device__ __forceinline__ void conv(LAS PhaseDesc* d, const float* src, int K, int N, void* dst, int Kp, int Np) {
        __builtin_amdgcn_sched_barrier(0);
        LAS Conv* c = cv + nc; ++nc; c->src = src; c->dst = (bf16_t*)dst; c->K = K; c->N = N; c->Kp = Kp; c->Np = Np; d->nconv = d->nconv + 1;
    }
};

__device__ __forceinline__ const float* vlaunder(const float* x) { asm volatile("" : "+v"(x)); return x; }
#define PIN(i) vlaunder(p.in[i])
#define H ((float*)(ws + OFF_H))
#define X6 ((bf16_t*)(ws + OFF_X6))
#define Rb ((float*)(ws + OFF_R))
#define Wb ((float*)(ws + OFF_W))
#define Kb ((float*)(ws + OFF_K))
#define Vb ((float*)(ws + OFF_V))
#define VFb ((float*)(ws + OFF_VF))
#define NAb ((float*)(ws + OFF_NA))
#define AAb ((float*)(ws + OFF_AA))
#define BONb ((float*)(ws + OFF_BON))
#define Yb ((float*)(ws + OFF_Y))
#define Gb ((float*)(ws + OFF_G))
#define TW ((bf16_t*)(ws + OFF_TW))
#define TA ((bf16_t*)(ws + OFF_TA))
#define TV ((bf16_t*)(ws + OFF_TV))
#define TG ((bf16_t*)(ws + OFF_TG))
#define Zb ((bf16_t*)(ws + OFF_Z))
#define UPT ((bf16_t*)(ws + OFF_MLPW))
#define DNT ((bf16_t*)(ws + OFF_MLPW + 32 * MiB))
#define KVN ((bf16_t*)(ws + OFF_KVN))
#define HN ((bf16_t*)(ws + OFF_HN))
#define KV ((bf16_t*)(ws + OFF_KV))
#define VTS ((bf16_t*)(ws + OFF_VTS))
#define VTW ((bf16_t*)(ws + OFF_VTW))
#define Qb ((bf16_t*)(ws + OFF_Q))
#define GATES ((float*)(ws + OFF_GATES))
#define ACMP ((bf16_t*)(ws + OFF_ACMP))
#define HID ((bf16_t*)(ws + OFF_HID))
#define KC ((bf16_t*)(ws + OFF_KC))
#define VCT ((bf16_t*)(ws + OFF_VCT))
#define Ob ((bf16_t*)(ws + OFF_O))
#define WKV ((bf16_t*)(ws + OFF_WKV))
#define C1 ((float*)(ws + OFF_C1))
#define C1P ((float*)(ws + OFF_C1P))
__device__ __forceinline__ void build_program(const Params& p, LAS unsigned char* lds0) {
    Builder b; b.pd = (LAS PhaseDesc*)(lds0 + LDS_DESC); b.jobs = (LAS Job*)(lds0 + LDS_JOBS); b.cv = (LAS Conv*)(lds0 + LDS_CONV); b.nph = 0; b.nj = 0; b.nc = 0;
    unsigned char* ws = p.ws; asm volatile("" : "+v"(ws));
    const size_t XS = (size_t)T * D;
    LAS PhaseDesc* d;
    asm volatile("" : "+v"(ws)); d = b.phase(K_NC); d->sub = 1; d->ptr[0] = H; d->ptr[6] = PIN(0); d->ptr[7] = PIN(25); d->ptr[8] = PIN(26); d->ptr[9] = C1P;
    {
        unsigned char* w2 = ws + OFF_RW;
        b.conv(d, PIN(3), D, D, w2 + RW_WR, D, D);
        b.conv(d, PIN(4), D, D, w2 + RW_WK, D, D);
        b.conv(d, PIN(5), D, D, w2 + RW_WV, D, D);
        b.conv(d, PIN(6), D, D, w2 + RW_WO, D, D);
        b.conv(d, PIN(8), D, 96, w2 + RW_W1, D, 256);
        b.conv(d, PIN(11), D, 128, w2 + RW_A1, D, 256);
        b.conv(d, PIN(16), D, 256, w2 + RW_G1, D, 256);
        b.conv(d, PIN(9), 96, D, w2 + RW_W2, 256, D);
        b.conv(d, PIN(12), 128, D, w2 + RW_A2, 256, D);
        b.conv(d, PIN(17), 256, D, w2 + RW_G2, 256, D);
    }
    auto mlp = [&](int L, bf16_t* XN, bf16_t* U) {
        asm volatile("" : "+v"(ws)); d = b.phase(K_NC); d->ptr[0] = H; d->ptr[1] = PIN(33) + (size_t)L * D; d->ptr[2] = XN;
        bf16_t* up_t = (L == 2) ? (bf16_t*)(ws + OFF_MLPW2) : UPT; bf16_t* dn_t = (L == 2) ? (bf16_t*)(ws + OFF_MLPW2 + 32 * MiB) : DNT;
        if (L == 3) {
            b.conv(d, PIN(34) + (size_t)L * D * DFF, D, DFF, UPT, D, DFF);
            b.conv(d, PIN(35) + (size_t)L * DFF * D, DFF, D, DNT, DFF, D);
        }
        asm volatile("" : "+v"(ws)); d = b.phase(K_GEMM); b.job(d, XN, up_t, U, nullptr, nullptr, 32, 32, DFF, EP_RELU2);
        asm volatile("" : "+v"(ws)); d = b.phase(K_GEMM); d->K = DFF; d->lda = DFF; d->ldb = DFF; b.job(d, U, dn_t, H, nullptr, nullptr, 32, 8, D, EP_RESID);
    };
#pragma unroll
    for (int i = 0; i < 2; ++i) {
        unsigned char* wb = ws + OFF_RW + i * RW_STRIDE;
        float* Vcur = (i == 0) ? VFb : Vb;
        asm volatile("" : "+v"(ws)); d = b.phase(K_MIX); d->ptr[0] = H; d->ptr[1] = PIN(1) + (size_t)i * D; d->ptr[2] = PIN(2) + (size_t)i * 6 * D; d->ptr[3] = X6;
        asm volatile("" : "+v"(ws)); d = b.phase(K_GEMM);
        b.job(d, X6 + 0 * XS, wb + RW_WR, Rb, nullptr, nullptr, 32, 8, D, EP_F32);
        b.job(d, X6 + 2 * XS, wb + RW_WK, Kb, nullptr, nullptr, 32, 8, D, EP_F32);
        b.job(d, X6 + 3 * XS, wb + RW_WV, Vcur, nullptr, nullptr, 32, 8, D, EP_F32);
        b.job(d, X6 + 1 * XS, wb + RW_W1, TW, nullptr, nullptr, 32, 1, 256, EP_TANH);
        b.job(d, X6 + 4 * XS, wb + RW_A1, TA, nullptr, nullptr, 32, 1, 256, EP_BF16);
        b.job(d, X6 + 5 * XS, wb + RW_G1, TG, nullptr, nullptr, 32, 1, 256, EP_SIGM);
        if (i == 1) b.job(d, X6 + 3 * XS, wb + RW_V1, TV, nullptr, nullptr, 32, 1, 256, EP_BF16);
        asm volatile("" : "+v"(ws)); d = b.phase(K_GEMM); d->K = 256; d->lda = 256; d->ldb = 256;
        b.job(d, TW, wb + RW_W2, Wb, PIN(7) + (size_t)i * D, nullptr, 32, 8, D, EP_DECAY);
        b.job(d, TA, wb + RW_A2, AAb, PIN(10) + (size_t)i * D, nullptr, 32, 8, D, EP_SIGB);
        b.job(d, TG, wb + RW_G2, Gb, nullptr, nullptr, 32, 8, D, EP_F32);
        if (i == 1) b.job(d, TV, wb + RW_V2, Vb, PIN(13), VFb, 32, 8, D, EP_VMIX);
        asm volatile("" : "+v"(ws)); d = b.phase(K_SCAN); d->ptr[0] = Rb; d->ptr[1] = Wb; d->ptr[2] = Kb; d->ptr[3] = Vcur; d->ptr[4] = AAb; d->ptr[5] = PIN(18) + (size_t)i * D; d->ptr[6] = Yb;
        d->ptr[7] = PIN(19) + (size_t)i * D; d->ptr[8] = PIN(20) + (size_t)i * D; d->ptr[9] = BONb;
        b.conv(d, PIN(34) + (size_t)i * D * DFF, D, DFF, UPT, D, DFF);
        b.conv(d, PIN(35) + (size_t)i * DFF * D, DFF, D, DNT, DFF, D);
        if (i == 0) {
            {
                unsigned char* w2 = ws + OFF_RW + RW_STRIDE;
                b.conv(d, PIN(3) + (size_t)D * D, D, D, w2 + RW_WR, D, D);
                b.conv(d, PIN(4) + (size_t)D * D, D, D, w2 + RW_WK, D, D);
                b.conv(d, PIN(5) + (size_t)D * D, D, D, w2 + RW_WV, D, D);
                b.conv(d, PIN(6) + (size_t)D * D, D, D, w2 + RW_WO, D, D);
                b.conv(d, PIN(8) + (size_t)D * 96, D, 96, w2 + RW_W1, D, 256);
                b.conv(d, PIN(11) + (size_t)D * 128, D, 128, w2 + RW_A1, D, 256);
                b.conv(d, PIN(16) + (size_t)D * 256, D, 256, w2 + RW_G1, D, 256);
                b.conv(d, PIN(9) + (size_t)96 * D, 96, D, w2 + RW_W2, 256, D);
                b.conv(d, PIN(12) + (size_t)128 * D, 128, D, w2 + RW_A2, 256, D);
                b.conv(d, PIN(17) + (size_t)256 * D, 256, D, w2 + RW_G2, 256, D);
                b.conv(d, PIN(14), D, 64, w2 + RW_V1, D, 256);
                b.conv(d, PIN(15), 64, D, w2 + RW_V2, 256, D);
            }
            b.conv(d, PIN(24), D, 3072, ws + OFF_WKV, D, 3072);
#pragma unroll
            for (int q = 0; q < 2; ++q) {
                b.conv(d, PIN(26) + (size_t)q * 4096 * 128, 4096, 128, ws + OFF_CW1 + q * 2 * MiB, 4096, 256);
                b.conv(d, PIN(28) + (size_t)q * 128 * 128, 128, 128, ws + OFF_CW2 + q * 131072, 256, 256);
                b.conv(d, PIN(30) + (size_t)q * D * 2096, D, 2096, ws + OFF_WQ + q * WQ_STRIDE, D, 2304);
                b.conv(d, PIN(31) + (size_t)q * D * D, D, D, ws + OFF_NWO + q * 8 * MiB, D, D);
            }
        } else {
            b.conv(d, PIN(34) + (size_t)2 * D * DFF, D, DFF, ws + OFF_MLPW2, D, DFF);
            b.conv(d, PIN(35) + (size_t)2 * DFF * D, DFF, D, ws + OFF_MLPW2 + 32 * MiB, DFF, D);
        }
        asm volatile("" : "+v"(ws)); d = b.phase(K_POST); d->ptr[0] = Yb; d->ptr[1] = BONb; d->ptr[2] = Vcur; d->ptr[3] = Gb; d->ptr[4] = PIN(21) + (size_t)i * D; d->ptr[5] = PIN(22) + (size_t)i * D; d->ptr[6] = Zb;
        asm volatile("" : "+v"(ws)); d = b.phase(K_GEMM); b.job(d, Zb, wb + RW_WO, H, nullptr, nullptr, 32, 8, D, EP_RESID);
        mlp(i, (bf16_t*)(ws + OFF_XN), (bf16_t*)(ws + OFF_U));
    }
#pragma unroll
    for (int j = 0; j < 2; ++j) {
        asm volatile("" : "+v"(ws)); d = b.phase(K_NC); d->ptr[0] = H;
        if (j == 0) { d->ptr[1] = PIN(23); d->ptr[2] = KVN; d->ptr[3] = PIN(29); d->ptr[4] = HN; }
        else { d->ptr[1] = PIN(29) + D; d->ptr[2] = HN; }
        asm volatile("" : "+v"(ws)); d = b.phase(K_GEMM);
        if (j == 0) {
            b.job(d, KVN, WKV, KV, nullptr, nullptr, 32, 6, 3072, EP_BF16);
            b.job(d, KVN, WKV + (size_t)2048 * D, KV + 2048, nullptr, nullptr, 32, 2, 3072, EP_BF16);
            b.job(d, WKV + (size_t)1536 * D, KVN, VTS, nullptr, nullptr, 2, 32, T, EP_BF16);
            b.job(d, WKV + (size_t)2560 * D, KVN, VTW, nullptr, nullptr, 2, 32, T, EP_BF16);
        }
        b.job(d, HN, ws + OFF_WQ + (size_t)j * WQ_STRIDE, Qb, GATES, nullptr, 32, 9, 2048, EP_Q);
        if (j == 0) {
            asm volatile("" : "+v"(ws)); d = b.phase(K_IM2COL); d->ptr[0] = KV; d->ptr[1] = ACMP; d->ptr[2] = C1P; d->ptr[3] = PIN(27); d->ptr[4] = C1;
            asm volatile("" : "+v"(ws)); d = b.phase(K_GEMM); d->K = 4096; d->lda = 4096; d->ldb = 4096;
            b.job(d, ACMP, ws + OFF_CW1, HID, C1, nullptr, 8, 1, 256, EP_GELU);
            b.job(d, ACMP + (size_t)2048 * 4096, ws + OFF_CW1 + 2 * MiB, HID + (size_t)2048 * 256, C1 + 256, nullptr, 8, 1, 256, EP_GELU);
            asm volatile("" : "+v"(ws)); d = b.phase(K_GEMM); d->K = 256; d->lda = 256; d->ldb = 256;
            b.job(d, HID, ws + OFF_CW2, KC, nullptr, nullptr, 8, 1, 256, EP_BF16);
            b.job(d, ws + OFF_CW2 + 131072, HID + (size_t)2048 * 256, VCT, nullptr, nullptr, 1, 8, 2048, EP_BF16);
        }
        asm volatile("" : "+v"(ws)); d = b.phase(K_ATTN); d->ptr[0] = Qb; d->ptr[1] = GATES; d->ptr[2] = KV; d->ptr[3] = VTS; d->ptr[4] = VTW; d->ptr[5] = KC; d->ptr[6] = VCT; d->ptr[7] = PIN(32); d->ptr[8] = Ob;
        asm volatile("" : "+v"(ws)); d = b.phase(K_GEMM); b.job(d, Ob, ws + OFF_NWO + (size_t)j * 8 * MiB, H, nullptr, nullptr, 32, 8, D, EP_RESID);
        mlp(2 + j, (bf16_t*)(ws + OFF_XN2), (bf16_t*)(ws + OFF_U2));
    }
    asm volatile("" : "+v"(ws)); d = b.phase(K_NC); d->ptr[0] = H; d->ptr[1] = PIN(36); { float* po = p.out; asm volatile("" : "+v"(po)); d->ptr[5] = po; }
}

#undef H
#undef X6
#undef Rb
#undef Wb
#undef Kb
#undef Vb
#undef VFb
#undef NAb
#undef AAb
#undef BONb
#undef Yb
#undef Gb
#undef TW
#undef TA
#undef TV
#undef TG
#undef Zb
#undef UPT
#undef DNT
#undef KVN
#undef HN
#undef KV
#undef VTS
#undef VTW
#undef Qb
#undef GATES
#undef ACMP
#undef HID
#undef KC
#undef VCT
#undef Ob
#undef WKV
#undef C1
#undef C1P
#undef PIN
#define XB_TMO      128
#define XB_XCNT(j)  (256  + 64 * (j))
#define XB_XSUB(j)  (1280 + 64 * (j))
#define XB_XGEN(j)  (2304 + 64 * (j))
#define XB_TOP      3328
#define XB_TOPGEN   3392
#define XCD_BAR_WORDS 3456
#define XB_SPIN_CAP (1u << 18)
constexpr size_t OFF_BAR = OFF_C1 + 16384;
__device__ __forceinline__ unsigned xb_ld(unsigned* p)              { return __hip_atomic_load(p, __ATOMIC_RELAXED, __HIP_MEMORY_SCOPE_AGENT); }
__device__ __forceinline__ unsigned xb_add(unsigned* p, unsigned v) { return __hip_atomic_fetch_add(p, v, __ATOMIC_RELAXED, __HIP_MEMORY_SCOPE_AGENT); }
__device__ __forceinline__ unsigned xb_xcc_id() { return (unsigned)__builtin_amdgcn_s_getreg((3 << 11) | 20) & 0xFu; }
#define XB_SPIN(cond, bar) do { unsigned _sp = 0; while (cond) { __builtin_amdgcn_s_sleep(1); \
    if ((++_sp & 255u) == 0u) { if (xb_ld(&(bar)[XB_TMO])) break; if (_sp > XB_SPIN_CAP) { atomicAdd(&(bar)[XB_TMO], 1u); break; } } } } while (0)
__device__ __forceinline__ void xcd_barrier_complete(unsigned* bar, unsigned x, unsigned& nloc, unsigned& nx) {
    const unsigned G = gridDim.x * gridDim.y * gridDim.z;
    unsigned sum, cnt, mine, sp = 0u;
    for (;;) {
        sum = 0u; cnt = 0u; mine = 0u;
#pragma unroll
        for (unsigned j = 0; j < 16; ++j) { const unsigned c = xb_ld(&bar[XB_XCNT(j)]); sum += c; cnt += (c > 0u) ? 1u : 0u; mine = (j == x) ? c : mine; }
        if (sum == G) break;
        __builtin_amdgcn_s_sleep(1);
        if ((++sp & 255u) == 0u) { if (xb_ld(&bar[XB_TMO])) break; if (sp > XB_SPIN_CAP) { atomicAdd(&bar[XB_TMO], 1u); break; } }
    }
    nloc = mine > 0u ? mine : 1u; nx = cnt > 0u ? cnt : 1u;
}
__device__ __forceinline__ void xcd_barrier(unsigned* bar, volatile LAS unsigned* st) {
    asm volatile("s_waitcnt vmcnt(0)" ::: "memory");
    __syncthreads();
    if (threadIdx.x == 0) {
        const unsigned x = xb_xcc_id();
        __builtin_amdgcn_s_waitcnt(0);
        unsigned nloc = st[0], nx = st[1];
        if (nloc == 0u) { xcd_barrier_complete(bar, x, nloc, nx); st[0] = nloc; st[1] = nx; }
        const unsigned old = xb_add(&bar[XB_XSUB(x)], 1u);
        const unsigned gen = old / nloc;
        if (old + 1u == (gen + 1u) * nloc) {
            __builtin_amdgcn_fence(__ATOMIC_RELEASE, "agent");
            asm volatile("s_waitcnt vmcnt(0)" ::: "memory");
            const unsigned og = xb_add(&bar[XB_TOP], 1u);
            const unsigned tg = og / nx;
            if (og + 1u == (tg + 1u) * nx) xb_add(&bar[XB_TOPGEN], 1u);
            else XB_SPIN(xb_ld(&bar[XB_TOPGEN]) == tg, bar);
            __builtin_amdgcn_fence(__ATOMIC_ACQUIRE, "agent");
            xb_add(&bar[XB_XGEN(x)], 1u);
            asm volatile("s_waitcnt vmcnt(0)" ::: "memory");
        } else {
            XB_SPIN(xb_ld(&bar[XB_XGEN(x)]) == gen, bar);
            __builtin_amdgcn_fence(__ATOMIC_ACQUIRE, "agent");
            asm volatile("s_waitcnt vmcnt(0)" ::: "memory");
        }
    }
    __syncthreads();
}

__global__ void __launch_bounds__(512, 2) mega(Params p) {
    extern __shared__ __attribute__((aligned(16))) unsigned char smem[];
    LAS unsigned char* lds0 = (LAS unsigned char*)smem;
    cg::grid_group grid = cg::this_grid();
    volatile LAS unsigned* bar_st = (volatile LAS unsigned*)(lds0 + LDS_DESC + NPH * 128 + 96);
    if (threadIdx.x == 0) {
        bar_st[0] = 0u; bar_st[1] = 0u;
        (void)xb_add(&((unsigned*)(p.ws + OFF_BAR))[XB_XCNT(xb_xcc_id())], 1u);
        build_program(p, lds0);
        LAS unsigned char* ord = lds0 + LDS_DESC + NPH * 128; int n = 0;
        for (int i = 0; i < NPH; ++i) {
            const LAS PhaseDesc* dd = (const LAS PhaseDesc*)(lds0 + LDS_DESC) + i;
            ord[n++] = (unsigned char)i;
            if (dd->kind == REP_KIND && dd->pad0) ord[n++] = (unsigned char)i;
        }
        ord[127] = (unsigned char)n;
    }
    __syncthreads();
    const int nord = __builtin_amdgcn_readfirstlane((int)lds0[LDS_DESC + NPH * 128 + 127]);
    for (int oi = 0; oi < nord; ++oi) {
        const int ph = __builtin_amdgcn_readfirstlane((int)lds0[LDS_DESC + NPH * 128 + oi]);
        const int tid = ltid(), nb = gridDim.x, bid = blockIdx.x;
        LAS unsigned char* lds = lds0 + LDS_WORK;
        const LAS PhaseDesc* d = (const LAS PhaseDesc*)(lds0 + LDS_DESC) + ph;
        const int kind = __builtin_amdgcn_readfirstlane(d->kind);
        if (kind == K_NC) {
            const float* Hh = uptr((const float*)d->ptr[0]);
            if (d->sub == 1) {
                const f32x4* xs = (const f32x4*)d->ptr[6];
                for (size_t i = (size_t)bid * 512 + tid; i < (size_t)T * D / 4; i += (size_t)nb * 512) ((f32x4*)Hh)[i] = xs[i];
                if (bid < 16) {
                    const int q = bid >> 3, ks = (bid & 7) * 4 + (tid >> 7), n = tid & 127;
                    const float* pe = (const float*)d->ptr[7] + (size_t)q * 4096; const float* w1 = (const float*)d->ptr[8] + (size_t)q * 4096 * 128;
                    float s = 0.f;
                    for (int k = ks * 128; k < ks * 128 + 128; ++k) s += pe[k] * w1[(size_t)k * 128 + n];
                    ((float*)d->ptr[9])[(q * 32 + ks) * 128 + n] = s;
                }
            }
            const float* g1 = uptr((const float*)d->ptr[1]);
            if (g1) phase_norm(Hh, g1, uptr((bf16_t*)d->ptr[2]), uptr((const float*)d->ptr[3]), uptr((bf16_t*)d->ptr[4]), uptr((float*)d->ptr[5]));
            __syncthreads();
            int off = 0;
            const int nconv = __builtin_amdgcn_readfirstlane(d->nconv), cfirst = __builtin_amdgcn_readfirstlane(d->cfirst);
            for (int c = 0; c < nconv; ++c) {
                const LAS Conv* cc = (const LAS Conv*)(lds0 + LDS_CONV) + cfirst + c;
                convT(uptr(cc->src), __builtin_amdgcn_readfirstlane(cc->K), __builtin_amdgcn_readfirstlane(cc->N), uptr(cc->dst), __builtin_amdgcn_readfirstlane(cc->Kp),
                      __builtin_amdgcn_readfirstlane(cc->Np), (LAS float*)lds, off);
            }
        } else if (kind == K_MIX) {
            phase_mix(uptr((const float*)d->ptr[0]), uptr((const float*)d->ptr[1]), uptr((const float*)d->ptr[2]), uptr((bf16_t*)d->ptr[3]));
        } else if (kind == K_GEMM) {
            gemm_phase(lds, (const LAS Job*)(lds0 + LDS_JOBS) + __builtin_amdgcn_readfirstlane(d->jfirst), __builtin_amdgcn_readfirstlane(d->njobs), __builtin_amdgcn_readfirstlane(d->total),
                       __builtin_amdgcn_readfirstlane(d->K), __builtin_amdgcn_readfirstlane(d->lda), __builtin_amdgcn_readfirstlane(d->ldb));
        } else if (kind == K_PREP) {
            phase_prep(uptr((const float*)d->ptr[0]), uptr((float*)d->ptr[1]), uptr((float*)d->ptr[2]), uptr((float*)d->ptr[3]), uptr((float*)d->ptr[4]),
                       uptr((const float*)d->ptr[5]), uptr((const float*)d->ptr[6]), uptr((const float*)d->ptr[7]));
        } else if (kind == K_SCAN) {
            phase_scan(uptr((const float*)d->ptr[0]), uptr((const float*)d->ptr[1]), uptr((const float*)d->ptr[2]), uptr((const float*)d->ptr[3]), uptr((const float*)d->ptr[4]),
                       uptr((const float*)d->ptr[5]), uptr((float*)d->ptr[6]), uptr((const float*)d->ptr[7]), uptr((const float*)d->ptr[8]), uptr((float*)d->ptr[9]), lds,
                       (const LAS Conv*)(lds0 + LDS_CONV) + __builtin_amdgcn_readfirstlane(d->cfirst), __builtin_amdgcn_readfirstlane(d->nconv));
        } else if (kind == K_POST) {
            phase_post(uptr((const float*)d->ptr[0]), uptr((const float*)d->ptr[1]), uptr((const float*)d->ptr[2]), uptr((const float*)d->ptr[3]), uptr((const float*)d->ptr[4]),
                       uptr((const float*)d->ptr[5]), uptr((bf16_t*)d->ptr[6]));
        } else if (kind == K_IM2COL) {
            const bf16_t* KV = uptr((const bf16_t*)d->ptr[0]); bf16_t* ACMP = uptr((bf16_t*)d->ptr[1]);
            for (size_t i = (size_t)bid * 512 + tid; i < (size_t)2 * 2048 * 512; i += (size_t)nb * 512) {
                const int k8 = (int)(i & 511), row = (int)((i >> 9) & 2047), q = (int)(i >> 20);
                const int c = row & 511, g = row >> 9, k = k8 * 8, l = k >> 7, dd = k & 127;
                u32x4 v = {0u, 0u, 0u, 0u};
                if (c < 511) v = *(const u32x4*)(KV + (size_t)(16 * c + l) * 3072 + q * 512 + g * 128 + dd);
                *(u32x4*)(ACMP + ((size_t)q * 2048 + row) * 4096 + k) = v;
            }
            if (bid == 0) {
                const int q = tid >> 8, n = tid & 255;
                float s = 0.f;
                if (n < 128) { s = ((const float*)d->ptr[3])[q * 128 + n]; for (int ks = 0; ks < 32; ++ks) s += ((const float*)d->ptr[2])[(q * 32 + ks) * 128 + n]; }
                ((float*)d->ptr[4])[q * 256 + n] = s;
            }
        } else {
            phase_attn(uptr((const bf16_t*)d->ptr[0]), uptr((const float*)d->ptr[1]), uptr((const bf16_t*)d->ptr[2]), uptr((const bf16_t*)d->ptr[3]), uptr((const bf16_t*)d->ptr[4]),
                       uptr((const bf16_t*)d->ptr[5]), uptr((const bf16_t*)d->ptr[6]), uptr((const float*)d->ptr[7]), uptr((bf16_t*)d->ptr[8]), lds);
        }
        if (oi == 0) grid.sync();
        else xcd_barrier((unsigned*)(p.ws + OFF_BAR), bar_st);
    }
}

extern "C" void kernel_launch(void* const* d_in, const int* in_sizes, int n_in, void* d_out, int out_size, void* d_ws, size_t ws_size, hipStream_t stream) {
    static int grid_blocks = 0;
    if (grid_blocks == 0) {
        if (n_in != 37 || ws_size < WS_NEED) { fprintf(stderr, "kernel_launch: unexpected n_in %d or ws_size %zu (need %zu)\n", n_in, ws_size, (size_t)WS_NEED); grid_blocks = -1; return; }
        int dev = 0, cus = 0, per_cu = 0;
        (void)hipGetDevice(&dev);
        (void)hipDeviceGetAttribute(&cus, hipDeviceAttributeMultiprocessorCount, dev);
        (void)hipFuncSetAttribute((const void*)mega, hipFuncAttributeMaxDynamicSharedMemorySize, LDS_BYTES);
        (void)hipOccupancyMaxActiveBlocksPerMultiprocessor(&per_cu, (const void*)mega, 512, LDS_BYTES);
        if (per_cu < 1) { fprintf(stderr, "kernel_launch: occupancy query returned %d\n", per_cu); per_cu = 1; }
        grid_blocks = cus * per_cu;
    }
    if (grid_blocks < 0) return;
    Params p{};
    for (int i = 0; i < 37; ++i) p.in[i] = (const float*)d_in[i];
    p.out = (float*)d_out; p.ws = (unsigned char*)d_ws;
    (void)hipMemsetAsync((unsigned char*)d_ws + OFF_BAR, 0, XCD_BAR_WORDS * sizeof(unsigned), stream);
    void* args[] = {&p};
    hipError_t e = hipLaunchCooperativeKernel((const void*)mega, dim3(grid_blocks), dim3(512), args, LDS_BYTES, stream);
    if (e != hipSuccess) fprintf(stderr, "cooperative launch failed: %s (grid %d)\n", hipGetErrorString(e), grid_blocks);
}
```
